# Optimizing an MI355X kernel written in HIP

```python
import math
import jax, jax.numpy as jnp
from jax import lax
import numpy as np

D_MODEL = 2048
BATCH = 2
SEQ = 8192
DEPTH = 4

GRID_W = 64
HEAD_DIM = 128
N_MIX_HEADS = D_MODEL // HEAD_DIM
MIX_WIDTH = N_MIX_HEADS * HEAD_DIM
N_FOURIER_GROUPS = 4
N_POOL_GROUPS = 4
POOL_WINDOWS = (2, 4, 8, 16)
GROUP_W = MIX_WIDTH // (N_FOURIER_GROUPS + N_POOL_GROUPS)
N_ATT_HEADS = N_MIX_HEADS // 2
N_KV_HEADS = 2
N_NA_HEADS = N_MIX_HEADS // 2
NA_WIN_ROWS = 8
NA_WIN_COLS = 16
Q_BLOCK = 128
ROPE_THETA = 10000.0
ATT_SPLITS = (N_ATT_HEADS * HEAD_DIM, N_KV_HEADS * HEAD_DIM, N_KV_HEADS * HEAD_DIM,
              N_NA_HEADS * HEAD_DIM, N_NA_HEADS * HEAD_DIM, N_NA_HEADS * HEAD_DIM)
ATT_IN_WIDTH = sum(ATT_SPLITS)
ATT_OUT_WIDTH = (N_ATT_HEADS + N_NA_HEADS) * HEAD_DIM
PEER_HEADS = 8
PEER_N_KEYS = 128
PEER_N_EXPERTS = PEER_N_KEYS ** 2
PEER_TOPK = 16
PEER_QUERY_DIM = 256
PEER_BLOCK = 128
DEEPNORM_ALPHA = (2.0 * DEPTH) ** 0.25
DEEPNORM_BETA = (8.0 * DEPTH) ** -0.25
LN_EPS = 1e-6
N_EVEN = (DEPTH + 1) // 2
N_ODD = DEPTH // 2

kernel_name = "hybrid_fourier_pool_gqa_natten_peer_encoder"


def _layer_norm(x):
    xf = x.astype(jnp.float32)
    mu = jnp.mean(xf, axis=-1, keepdims=True)
    var = jnp.mean(jnp.square(xf - mu), axis=-1, keepdims=True)
    return (xf - mu) * lax.rsqrt(var + LN_EPS)


def _post_norm(x, g, b):
    return (_layer_norm(x) * g.astype(jnp.float32) + b.astype(jnp.float32)).astype(x.dtype)


def _rms_norm(x, g):
    xf = x.astype(jnp.float32)
    y = xf * lax.rsqrt(jnp.mean(jnp.square(xf), axis=-1, keepdims=True) + LN_EPS)
    return (y * g.astype(jnp.float32)).astype(x.dtype)


def _adaln(c, w, b):
    m = c @ w + b
    shift, scale, gate = jnp.split(m, 3, axis=-1)
    return shift[:, None, :], scale[:, None, :], (1.0 + gate)[:, None, :]


def _modulate(x, shift, scale):
    return (_layer_norm(x) * (1.0 + scale.astype(jnp.float32)) + shift.astype(jnp.float32)).astype(x.dtype)


def _fourier_mix(z, w_fourier):
    zf = jnp.fft.fftn(z.astype(jnp.float32), axes=(1, 3), norm="ortho").real
    return jnp.einsum('bsgc,gcd->bsgd', zf.astype(z.dtype), w_fourier)


def _pool_mix(z, w_pool, pool_scale):
    B, S, G, Cg = z.shape
    zf = z.astype(jnp.float32)
    cs = jnp.concatenate([jnp.zeros((B, 1, G, Cg), jnp.float32), jnp.cumsum(zf, axis=1)], axis=1)
    t = jnp.arange(S)
    outs = []
    for g, w in enumerate(POOL_WINDOWS):
        lo = jnp.clip(t - w // 2, 0, S)
        hi = jnp.clip(t + w // 2, 0, S)
        csg = cs[:, :, g]
        sums = jnp.take(csg, hi, axis=1) - jnp.take(csg, lo, axis=1)
        cnt = (hi - lo).astype(jnp.float32)[None, :, None]
        outs.append(sums / cnt - zf[:, :, g])
    p = jnp.stack(outs, axis=2).astype(z.dtype)
    y = jnp.einsum('bsgc,gcd->bsgd', p, w_pool)
    return y * pool_scale.reshape(G, Cg)


def _fourier_pool_mixer(h, w_in, w_fourier, w_pool, pool_scale, w_out):
    B, S, _ = h.shape
    z = (h @ w_in).reshape(B, S, N_FOURIER_GROUPS + N_POOL_GROUPS, GROUP_W)
    ya = _fourier_mix(z[:, :, :N_FOURIER_GROUPS], w_fourier)
    yb = _pool_mix(z[:, :, N_FOURIER_GROUPS:], w_pool, pool_scale)
    y = jnp.concatenate([ya, yb], axis=2).reshape(B, S, MIX_WIDTH)
    return y @ w_out


def _rope_half(x, pos):
    half = x.shape[-1] // 2
    inv_freq = ROPE_THETA ** (-jnp.arange(half, dtype=jnp.float32) / half)
    ang = pos.astype(jnp.float32)[:, None] * inv_freq[None, :]
    cos = jnp.cos(ang)[None, :, None, :]
    sin = jnp.sin(ang)[None, :, None, :]
    xf = x.astype(jnp.float32)
    x1, x2 = xf[..., :half], xf[..., half:]
    return jnp.concatenate([x1 * cos - x2 * sin, x2 * cos + x1 * sin], axis=-1).astype(x.dtype)


def _axial_rope(x):
    S = x.shape[1]
    t = jnp.arange(S)
    d = x.shape[-1] // 2
    return jnp.concatenate([_rope_half(x[..., :d], t // GRID_W), _rope_half(x[..., d:], t % GRID_W)], axis=-1)


def _gqa_attention(q, k, v):
    B, S, Hq, Dh = q.shape
    Hkv = k.shape[2]
    G = Hq // Hkv
    nb = S // Q_BLOCK
    qb = q.reshape(B, nb, Q_BLOCK, Hkv, G, Dh).transpose(1, 0, 2, 3, 4, 5)
    scale = Dh ** -0.5

    def block(qi):
        s = jnp.einsum('bqkgd,bskd->bkgqs', qi, k).astype(jnp.float32) * scale
        p = jax.nn.softmax(s, axis=-1).astype(v.dtype)
        return jnp.einsum('bkgqs,bskd->bqkgd', p, v)

    o = lax.map(block, qb)
    return o.transpose(1, 0, 2, 3, 4, 5).reshape(B, S, Hq * Dh)


def _neighbourhood_attention(q, k, v, rpb):
    B, S, H, Dh = q.shape
    rows = S // GRID_W
    wr = min(NA_WIN_ROWS, rows)
    wc = NA_WIN_COLS
    qg = q.reshape(B, rows, GRID_W, H, Dh)
    kg = k.reshape(B, rows, GRID_W, H, Dh)
    vg = v.reshape(B, rows, GRID_W, H, Dh)
    cols = np.arange(GRID_W)
    col_start = np.clip(cols - wc // 2, 0, GRID_W - wc)
    col_idx = col_start[:, None] + np.arange(wc)[None, :]
    col_off = col_idx - cols[:, None] + (NA_WIN_COLS - 1)
    bias_cols = rpb[:, :, col_off]
    scale = Dh ** -0.5

    def row_fn(r):
        rs = jnp.clip(r - wr // 2, 0, rows - wr)
        kr = lax.dynamic_slice_in_dim(kg, rs, wr, axis=1)[:, :, col_idx]
        vr = lax.dynamic_slice_in_dim(vg, rs, wr, axis=1)[:, :, col_idx]
        qr = lax.dynamic_index_in_dim(qg, r, axis=1, keepdims=False)
        s = jnp.einsum('bjhd,bijwhd->bhjiw', qr, kr).astype(jnp.float32) * scale
        row_off = rs + jnp.arange(wr) - r + (NA_WIN_ROWS - 1)
        bias = jnp.take(bias_cols, row_off, axis=1)
        s = s + bias.transpose(0, 2, 1, 3)[None].astype(jnp.float32)
        p = jax.nn.softmax(s.reshape(B, H, GRID_W, wr * wc), axis=-1).reshape(s.shape).astype(v.dtype)
        return jnp.einsum('bhjiw,bijwhd->bjhd', p, vr)

    o = lax.map(row_fn, jnp.arange(rows))
    return o.transpose(1, 0, 2, 3, 4).reshape(B, S, H * Dh)


def _attention_mixer(h, w_in, q_norm, k_norm, rpb, w_out):
    B, S, _ = h.shape
    proj = h @ w_in
    splits = np.cumsum(ATT_SPLITS)[:-1].tolist()
    qc, kc, vc, qd, kd, vd = jnp.split(proj, splits, axis=-1)
    qc = qc.reshape(B, S, N_ATT_HEADS, HEAD_DIM)
    kc = kc.reshape(B, S, N_KV_HEADS, HEAD_DIM)
    vc = vc.reshape(B, S, N_KV_HEADS, HEAD_DIM)
    qc = _axial_rope(_rms_norm(qc, q_norm))
    kc = _axial_rope(_rms_norm(kc, k_norm))
    yc = _gqa_attention(qc, kc, vc)
    qd = qd.reshape(B, S, N_NA_HEADS, HEAD_DIM)
    kd = kd.reshape(B, S, N_NA_HEADS, HEAD_DIM)
    vd = vd.reshape(B, S, N_NA_HEADS, HEAD_DIM)
    yd = _neighbourhood_attention(qd, kd, vd, rpb)
    return jnp.concatenate([yc, yd], axis=-1) @ w_out


def _peer(h, w_q, sub_keys, u, v):
    B, S, D = h.shape
    K = PEER_TOPK
    dh = PEER_QUERY_DIM // 2
    q = (h @ w_q).reshape(B, S, PEER_HEADS, 2, dh)
    s = jnp.einsum('bshpd,hpnd->bshpn', q, sub_keys).astype(jnp.float32)
    s1, i1 = lax.top_k(s[..., 0, :], K)
    s2, i2 = lax.top_k(s[..., 1, :], K)
    cand = (s1[..., :, None] + s2[..., None, :]).reshape(B, S, PEER_HEADS, K * K)
    sc, ci = lax.top_k(cand, K)
    e1 = jnp.take_along_axis(i1, ci // K, axis=-1)
    e2 = jnp.take_along_axis(i2, ci % K, axis=-1)
    experts = (e1 * PEER_N_KEYS + e2).reshape(B, S, PEER_HEADS * K)
    gates = jax.nn.softmax(sc, axis=-1).reshape(B, S, PEER_HEADS * K).astype(h.dtype)
    nb = S // PEER_BLOCK

    def to_blocks(a):
        return a.reshape(B, nb, PEER_BLOCK, *a.shape[2:]).swapaxes(0, 1)

    def block(args):
        hb, eb, gb = args
        ub = jnp.take(u, eb, axis=0)
        a = jax.nn.gelu(jnp.einsum('bqd,bqed->bqe', hb, ub), approximate=False)
        vb = jnp.take(v, eb, axis=0)
        return jnp.einsum('bqe,bqed->bqd', gb * a, vb)

    y = lax.map(block, (to_blocks(h), to_blocks(experts), to_blocks(gates)))
    return y.swapaxes(0, 1).reshape(B, S, D)


def setup_inputs(seed: int = 0) -> dict:
    key = jax.random.key(seed)
    ks = jax.random.split(key, 20)
    D = D_MODEL
    f32 = jnp.float32
    nrm = lambda k, shape, s: jax.random.normal(k, shape, f32) * s
    x = nrm(ks[0], (BATCH, SEQ, D), 1.0)
    c = nrm(ks[1], (BATCH, D), 1.0)
    ada_w = nrm(ks[2], (DEPTH, 2, D, 3 * D), 0.1 * D ** -0.5)
    ada_b = nrm(ks[3], (DEPTH, 2, 3 * D), 0.01)
    ln_g = 1.0 + nrm(ks[4], (DEPTH, 2, D), 0.02)
    ln_b = nrm(ks[5], (DEPTH, 2, D), 0.02)
    fp_w_in = nrm(ks[6], (N_EVEN, D, MIX_WIDTH), D ** -0.5)
    fp_w_fourier = nrm(ks[7], (N_EVEN, N_FOURIER_GROUPS, GROUP_W, GROUP_W), GROUP_W ** -0.5)
    fp_w_pool = nrm(ks[8], (N_EVEN, N_POOL_GROUPS, GROUP_W, GROUP_W), GROUP_W ** -0.5)
    fp_pool_scale = 1.0 + nrm(ks[9], (N_EVEN, N_POOL_GROUPS * GROUP_W), 0.1)
    fp_w_out = nrm(ks[10], (N_EVEN, MIX_WIDTH, D), DEEPNORM_BETA * MIX_WIDTH ** -0.5)
    col_scale = jnp.concatenate([
        jnp.full((w,), DEEPNORM_BETA if i in (2, 5) else 1.0, f32) for i, w in enumerate(ATT_SPLITS)])
    at_w_in = nrm(ks[11], (N_ODD, D, ATT_IN_WIDTH), D ** -0.5) * col_scale
    at_q_norm = 1.0 + nrm(ks[12], (N_ODD, HEAD_DIM), 0.02)
    at_k_norm = 1.0 + nrm(ks[13], (N_ODD, HEAD_DIM), 0.02)
    at_rpb = nrm(ks[14], (N_ODD, N_NA_HEADS, 2 * NA_WIN_ROWS - 1, 2 * NA_WIN_COLS - 1), 0.1)
    at_w_out = nrm(ks[15], (N_ODD, ATT_OUT_WIDTH, D), DEEPNORM_BETA * ATT_OUT_WIDTH ** -0.5)
    peer_w_q = nrm(ks[16], (DEPTH, D, PEER_HEADS * PEER_QUERY_DIM), D ** -0.5)
    peer_sub_keys = nrm(ks[17], (DEPTH, PEER_HEADS, 2, PEER_N_KEYS, PEER_QUERY_DIM // 2),
                        (PEER_QUERY_DIM // 2) ** -0.5)
    peer_u = nrm(ks[18], (DEPTH, PEER_N_EXPERTS, D), D ** -0.5)
    peer_v = nrm(ks[19], (DEPTH, PEER_N_EXPERTS, D), DEEPNORM_BETA * PEER_HEADS ** -0.5)
    return {"x": x, "c": c, "ada_w": ada_w, "ada_b": ada_b, "ln_g": ln_g, "ln_b": ln_b,
            "fp_w_in": fp_w_in, "fp_w_fourier": fp_w_fourier, "fp_w_pool": fp_w_pool,
            "fp_pool_scale": fp_pool_scale, "fp_w_out": fp_w_out,
            "at_w_in": at_w_in, "at_q_norm": at_q_norm, "at_k_norm": at_k_norm,
            "at_rpb": at_rpb, "at_w_out": at_w_out,
            "peer_w_q": peer_w_q, "peer_sub_keys": peer_sub_keys, "peer_u": peer_u, "peer_v": peer_v}


def reference(x, c, ada_w, ada_b, ln_g, ln_b, fp_w_in, fp_w_fourier, fp_w_pool, fp_pool_scale,
              fp_w_out, at_w_in, at_q_norm, at_k_norm, at_rpb, at_w_out,
              peer_w_q, peer_sub_keys, peer_u, peer_v):
    for l in range(DEPTH):
        i = l // 2
        shift, scale, gate = _adaln(c, ada_w[l, 0], ada_b[l, 0])
        h = _modulate(x, shift, scale)
        if l % 2 == 0:
            y = _fourier_pool_mixer(h, fp_w_in[i], fp_w_fourier[i], fp_w_pool[i], fp_pool_scale[i], fp_w_out[i])
        else:
            y = _attention_mixer(h, at_w_in[i], at_q_norm[i], at_k_norm[i], at_rpb[i], at_w_out[i])
        x = _post_norm(DEEPNORM_ALPHA * x + gate * y, ln_g[l, 0], ln_b[l, 0])
        shift, scale, gate = _adaln(c, ada_w[l, 1], ada_b[l, 1])
        h = _modulate(x, shift, scale)
        y = _peer(h, peer_w_q[l], peer_sub_keys[l], peer_u[l], peer_v[l])
        x = _post_norm(DEEPNORM_ALPHA * x + gate * y, ln_g[l, 1], ln_b[l, 1])
    return x
```

```cpp
#include <hip/hip_runtime.h>
#include <cstdio>
#include <cstdint>

#ifndef MK_SINGLE_LAUNCH
#define MK_SINGLE_LAUNCH 1
#endif

#define LAS __attribute__((address_space(3)))
typedef unsigned short bf16_t;
typedef short bf16x8 __attribute__((ext_vector_type(8)));
typedef short s16x4 __attribute__((ext_vector_type(4)));
typedef float f32x4 __attribute__((ext_vector_type(4)));
typedef float f32x2 __attribute__((ext_vector_type(2)));
typedef float f32x8 __attribute__((ext_vector_type(8)));
typedef float f32x16 __attribute__((ext_vector_type(16)));
typedef unsigned u32x4 __attribute__((ext_vector_type(4)));
typedef unsigned u32x2 __attribute__((ext_vector_type(2)));

constexpr int DM = 2048, NBATCH = 2, SEQ = 8192, NTOK = NBATCH * SEQ, DEPTH = 4;
constexpr int ATT_IN = 4608;
constexpr int NEXP = 16384;
constexpr float ALPHA = 1.6817928305074290f;
constexpr float LN_EPS = 1e-6f;
constexpr float ATT_SCALE = 0.088388347648318440f;
constexpr float FOURIER_SCALE = 6.9053396600248786e-4f;
constexpr int NTHREADS = 512, NWAVES = 8;
constexpr int LDS_BYTES = 147456;

constexpr size_t al256(size_t x) { return (x + 255) / 256 * 256; }
constexpr size_t WS_BAR   = 0;
constexpr size_t WS_MODP  = 16384;
constexpr size_t WS_MOD   = WS_MODP + (size_t)8 * 32 * 2 * 6144 * 4;
constexpr size_t WS_TW    = WS_MOD + (size_t)8 * 2 * 6144 * 4;
constexpr size_t WS_ROPE  = WS_TW + 8192 * 8;
constexpr size_t WS_WFPIN = WS_ROPE + 128 * 32 * 8;
constexpr size_t WS_WFPOUT= WS_WFPIN + (size_t)2 * 2048 * 2048 * 2;
constexpr size_t WS_WATIN = WS_WFPOUT + (size_t)2 * 2048 * 2048 * 2;
constexpr size_t WS_WATOUT= WS_WATIN + (size_t)2 * 4608 * 2048 * 2;
constexpr size_t WS_WPQ   = WS_WATOUT + (size_t)2 * 2048 * 2048 * 2;
constexpr size_t WS_WFW   = WS_WPQ + (size_t)4 * 2048 * 2048 * 2;
constexpr size_t WS_WPW   = WS_WFW + (size_t)2 * 4 * 512 * 256 * 2;
constexpr size_t WS_WSK   = WS_WPW + (size_t)2 * 4 * 256 * 256 * 2;
constexpr size_t WS_UB    = WS_WSK + (size_t)4 * 8 * 256 * 256 * 2;
constexpr size_t WS_VB    = WS_UB + (size_t)4 * NEXP * 1024;
constexpr size_t WS_SU    = WS_VB + (size_t)4 * NEXP * 1024;
constexpr size_t WS_SV    = WS_SU + (size_t)4 * NEXP * 64 * 2;
constexpr size_t WS_H8    = WS_SV + (size_t)4 * NEXP * 64 * 2;
constexpr size_t WS_HS    = WS_H8 + (size_t)NTOK * DM;
constexpr size_t WS_XA    = WS_HS + (size_t)NTOK * 4;
constexpr size_t WS_XU    = WS_XA + (size_t)NTOK * DM * 4;
constexpr size_t WS_H     = WS_XU + (size_t)NTOK * DM * 4;
constexpr size_t WS_PROJ  = WS_H + (size_t)NTOK * DM * 2;
constexpr size_t WS_YMIX  = WS_PROJ + (size_t)NTOK * ATT_IN * 2;
constexpr size_t WS_PQ    = WS_YMIX + (size_t)NTOK * DM * 2;
constexpr size_t WS_YR    = WS_PQ + (size_t)NTOK * DM * 4;
constexpr size_t WS_YI    = WS_YR + (size_t)NTOK * 1024 * 4;
constexpr size_t WS_PBUF  = WS_YI + (size_t)NTOK * 1024 * 4;
constexpr size_t WS_QP    = WS_PBUF + (size_t)NTOK * 1024 * 2;
constexpr size_t WS_EIDX  = WS_QP + (size_t)NTOK * DM * 2;
constexpr size_t WS_EG    = WS_EIDX + (size_t)NTOK * 128 * 4;
constexpr size_t WS_WSC   = WS_EG + (size_t)NTOK * 128 * 4;
constexpr size_t WS_KC    = WS_WSC + (size_t)4 * 2048 * 2048 * 2;
constexpr size_t WS_VC    = WS_KC + (size_t)NTOK * 256 * 2;
constexpr size_t WS_LNS   = WS_VC + (size_t)NTOK * 256 * 2;
constexpr size_t WS_COEF  = WS_LNS + (size_t)NTOK * 2 * 4;
constexpr size_t WS_PW    = WS_COEF + (size_t)NTOK * 128 * 4;
constexpr size_t WS_WSC8  = WS_PW + (size_t)NTOK * 8 * 128 * 2;
constexpr size_t WS_WSS   = WS_WSC8 + (size_t)4 * 2048 * 2048;
constexpr size_t WS_WIN8  = WS_WSS + (size_t)4 * 2048 * 4;
constexpr size_t WS_WINS  = WS_WIN8 + (size_t)(2 * 2048 + 2 * 4608) * 2048;
constexpr size_t WS_HS2   = WS_WINS + (size_t)(2 * 2048 + 2 * 4608) * 4;
constexpr size_t WS_WOUT8 = WS_HS2 + (size_t)NTOK * 4;
constexpr size_t WS_WOUTS = WS_WOUT8 + (size_t)4 * 2048 * 2048;
constexpr size_t WS_YS    = WS_WOUTS + (size_t)4 * 2048 * 4;
constexpr size_t WS_END   = WS_YS + (size_t)NTOK * 4;

struct Params {
    const float *x, *c, *ada_w, *ada_b, *ln_g, *ln_b, *fp_w_in, *fp_w_fourier, *fp_w_pool, *fp_pool_scale, *fp_w_out;
    const float *at_w_in, *at_q_norm, *at_k_norm, *at_rpb, *at_w_out, *peer_w_q, *peer_sub_keys, *peer_u, *peer_v;
    float* out; unsigned char* ws;
};

__device__ __forceinline__ float bf2f(bf16_t v) { return __uint_as_float(((unsigned)v) << 16); }
__device__ __forceinline__ float bflo(unsigned w) { return __uint_as_float(w << 16); }
__device__ __forceinline__ float bfhi(unsigned w) { return __uint_as_float(w & 0xffff0000u); }
__device__ __forceinline__ unsigned cvt_pk_bf16(float lo, float hi) { unsigned r; asm volatile("v_cvt_pk_bf16_f32 %0, %1, %2" : "=v"(r) : "v"(lo), "v"(hi)); return r; }
__device__ __forceinline__ bf16_t f2bf(float f) { return (bf16_t)(cvt_pk_bf16(f, 0.f) & 0xffffu); }
#define DPPF(v, ctrl) __int_as_float(__builtin_amdgcn_update_dpp(0, __float_as_int(v), (ctrl), 0xF, 0xF, true))
#define RDL(v, l) __int_as_float(__builtin_amdgcn_readlane(__float_as_int(v), (l)))
__device__ __forceinline__ float wave_sum(float v) {
    v += DPPF(v, 0xB1); v += DPPF(v, 0x4E); v += DPPF(v, 0x141); v += DPPF(v, 0x140);
    return (RDL(v, 0) + RDL(v, 16)) + (RDL(v, 32) + RDL(v, 48));
}
__device__ __forceinline__ float wave_max(float v) {
    v = fmaxf(v, DPPF(v, 0xB1)); v = fmaxf(v, DPPF(v, 0x4E)); v = fmaxf(v, DPPF(v, 0x141)); v = fmaxf(v, DPPF(v, 0x140));
    return fmaxf(fmaxf(RDL(v, 0), RDL(v, 16)), fmaxf(RDL(v, 32), RDL(v, 48)));
}
__device__ __forceinline__ float gelu_erf(float v) { return 0.5f * v * (1.0f + erff(v * 0.70710678118654752f)); }

#define XB_TMO      128
#define XB_XCNT(j)  (256  + 64 * (j))
#define XB_XSUB(j)  (1280 + 64 * (j))
#define XB_XGEN(j)  (2304 + 64 * (j))
#define XB_TOP      3328
#define XB_TOPGEN   3392
#define XCD_BAR_WORDS 3456
#define XB_SPIN_CAP (1u << 18)

__device__ __forceinline__ unsigned xb_ld(unsigned* p)              { return __hip_atomic_load(p, __ATOMIC_RELAXED, __HIP_MEMORY_SCOPE_AGENT); }
__device__ __forceinline__ unsigned xb_add(unsigned* p, unsigned v) { return __hip_atomic_fetch_add(p, v, __ATOMIC_RELAXED, __HIP_MEMORY_SCOPE_AGENT); }
__device__ __forceinline__ unsigned xb_xcc_id() { return (unsigned)__builtin_amdgcn_s_getreg((3 << 11) | 20) & 0xFu; }
#define XB_SPIN(cond, bar) do { unsigned _sp = 0; while (cond) { __builtin_amdgcn_s_sleep(1); \
    if ((++_sp & 255u) == 0u) { if (xb_ld(&(bar)[XB_TMO])) break; if (_sp > XB_SPIN_CAP) { atomicAdd(&(bar)[XB_TMO], 1u); break; } } } } while (0)

struct XcdBarrier { unsigned* bar; unsigned x; volatile LAS unsigned* st; };

__device__ __forceinline__ XcdBarrier xcd_barrier_post(unsigned* bar, volatile LAS unsigned* st) {
    XcdBarrier b; b.bar = bar; b.x = xb_xcc_id(); b.st = st;
    if (threadIdx.x == 0) (void)xb_add(&bar[XB_XCNT(b.x)], 1u);
    return b;
}
__device__ __forceinline__ void xcd_barrier_complete(unsigned* bar, unsigned x, unsigned& nloc, unsigned& nx) {
    const unsigned G = gridDim.x * gridDim.y * gridDim.z;
    unsigned sum, cnt, mine, sp = 0u;
    for (;;) {
        sum = 0u; cnt = 0u; mine = 0u;
#pragma unroll
        for (unsigned j = 0; j < 16; ++j) { const unsigned c = xb_ld(&bar[XB_XCNT(j)]); sum += c; cnt += (c > 0u) ? 1u : 0u; mine = (j == x) ? c : mine; }
        if (sum == G) break;
        __builtin_amdgcn_s_sleep(1);
        if ((++sp & 255u) == 0u) { if (xb_ld(&bar[XB_TMO])) break; if (sp > XB_SPIN_CAP) { atomicAdd(&bar[XB_TMO], 1u); break; } }
    }
    nloc = mine > 0u ? mine : 1u; nx = cnt > 0u ? cnt : 1u;
}
__device__ __forceinline__ void xcd_barrier(const XcdBarrier& b, const bool leader) {
    asm volatile("s_waitcnt vmcnt(0)" ::: "memory");
    __syncthreads();
    if (leader) {
        unsigned* bar = b.bar;
        __builtin_amdgcn_s_waitcnt(0);
        unsigned nloc = b.st[0], nx = b.st[1];
        if (nloc == 0u) { xcd_barrier_complete(bar, b.x, nloc, nx); b.st[0] = nloc; b.st[1] = nx; }
        const unsigned old = xb_add(&bar[XB_XSUB(b.x)], 1u);
        const unsigned gen = old / nloc;
        if (old + 1u == (gen + 1u) * nloc) {
            __builtin_amdgcn_fence(__ATOMIC_RELEASE, "agent");
            asm volatile("s_waitcnt vmcnt(0)" ::: "memory");
            const unsigned og = xb_add(&bar[XB_TOP], 1u);
            const unsigned tg = og / nx;
            if (og + 1u == (tg + 1u) * nx) xb_add(&bar[XB_TOPGEN], 1u);
            else XB_SPIN(xb_ld(&bar[XB_TOPGEN]) == tg, bar);
            __builtin_amdgcn_fence(__ATOMIC_ACQUIRE, "agent");
            xb_add(&bar[XB_XGEN(b.x)], 1u);
            asm volatile("s_waitcnt vmcnt(0)" ::: "memory");
        } else {
            XB_SPIN(xb_ld(&bar[XB_XGEN(b.x)]) == gen, bar);
            __builtin_amdgcn_fence(__ATOMIC_ACQUIRE, "agent");
            asm volatile("s_waitcnt vmcnt(0)" ::: "memory");
        }
    }
    __syncthreads();
}

namespace pg8 {
typedef int i32x4_t __attribute__((ext_vector_type(4)));
constexpr int BM = 256, BK = 64, HALF = 128, HTB = HALF * BK * 2, STAGE_BYTES = 8 * HTB, NXCD = 8, WGM = 8;
__host__ __device__ __forceinline__ int lds_byte(int r, int c) { const int st = (r >> 4) * 2 + (c >> 5), rr = r & 15, cc = c & 31, ob = rr * 64 + cc * 2; return st * 1024 + (ob ^ (((ob >> 9) & 1) << 5)); }
__host__ __device__ __forceinline__ void stage_rc(int b, int& R, int& C) { const int st = b / 1024, sb = b % 1024, swz = sb ^ (((sb >> 9) & 1) << 5); R = (st >> 1) * 16 + swz / 64; C = (st & 1) * 32 + (swz % 64) / 2; }
__host__ __device__ __forceinline__ int perm32(int rho) { const int n = rho >> 4, i = rho & 15; return 8 * (i >> 2) + 4 * n + (i & 3); }
struct Unit { int pm, pn; };
struct StaticOrder {
    int nM, nN, nwg, G, c;
    __device__ void init(int nM_, int nN_, int G_, int c_) { nM = nM_; nN = nN_; nwg = nM * nN; G = G_; c = c_; }
    __device__ bool next(int i, Unit& u) const {
        const long L = (long)i * G + c; if (L >= nwg) return false;
        int wgid = (int)L; { const int q = nwg / NXCD, r = nwg % NXCD, xcd = wgid % NXCD, off = wgid / NXCD; wgid = (xcd < r ? xcd * (q + 1) : r * (q + 1) + (xcd - r) * q) + off; }
        const int nig = WGM * nN, gid = wgid / nig, fm = gid * WGM, gsz = (nM - fm) < WGM ? (nM - fm) : WGM;
        u.pm = fm + ((wgid % nig) % gsz); u.pn = (wgid % nig) / gsz; return true;
    }
};
struct PlainOps {
    const bf16_t* A; const bf16_t* Bt; int lda, ldb;
    __device__ __forceinline__ const char* a(const Unit& u) const { return (const char*)(A + (size_t)u.pm * BM * lda); }
    __device__ __forceinline__ const char* b(const Unit& u) const { return (const char*)(Bt + (size_t)u.pn * BM * ldb); }
};
struct GroupOps {
    const bf16_t* A; const bf16_t* Bt; int lda, ldb, tpg, a_gstride;
    __device__ __forceinline__ const char* a(const Unit& u) const { return (const char*)(A + (size_t)u.pm * BM * lda + (size_t)(u.pn / tpg) * a_gstride); }
    __device__ __forceinline__ const char* b(const Unit& u) const { return (const char*)(Bt + (size_t)u.pn * BM * ldb); }
};

struct ScoreFoldOps {
    const bf16_t* A; const bf16_t* B;
    static constexpr int lda = 256, ldb = 2048;
    __device__ __forceinline__ const char* a(const Unit& u) const { return (const char*)(A + (size_t)u.pm * 65536); }
    __device__ __forceinline__ const char* b(const Unit& u) const { return (const char*)(B + (size_t)(u.pm >> 3) * 2048 * 2048 + (size_t)u.pn * BM * 2048 + (u.pm & 7) * 256); }
};
struct EpiF32 {
    static constexpr bool PERM = false;
    float* C; int ldc;
    __device__ __forceinline__ void operator()(const f32x4 (&acc)[2][2][4][2], const Unit& u, int wr, int wc, int fr, int fq) const {
        const int row0 = u.pm * BM + wr * 64 + fr, col0 = u.pn * BM + wc * 32 + 4 * fq;
#pragma unroll
        for (int ai = 0; ai < 2; ++ai)
#pragma unroll
            for (int m = 0; m < 4; ++m) { float* rowp = C + (size_t)(row0 + ai * HALF + m * 16) * ldc + col0;
#pragma unroll
                for (int bj = 0; bj < 2; ++bj)
#pragma unroll
                    for (int n = 0; n < 2; ++n) *(f32x4*)(rowp + bj * HALF + n * 16) = acc[ai][bj][m][n]; }
    }
};
template <bool XB  , bool I8 = false  >
struct EpiResid {
    static constexpr bool PERM = true;
    bf16_t* U; const void* X; const float* gate;
    const float* rowscale; const float* colscale;
    __device__ __forceinline__ void operator()(const f32x4 (&acc)[2][2][4][2], const Unit& u, int wr, int wc, int fr, int fq) const {
        const int row0 = u.pm * BM + wr * 64 + fr, col0 = u.pn * BM + wc * 32 + 8 * fq;
        const float* gp = gate + (size_t)((u.pm * BM) / SEQ) * 6144 + col0;
        f32x4 gv[2][2];
#pragma unroll
        for (int bj = 0; bj < 2; ++bj)
#pragma unroll
            for (int n = 0; n < 2; ++n) { gv[bj][n] = *(const f32x4*)(gp + bj * HALF + 4 * n); if constexpr (I8) gv[bj][n] *= *(const f32x4*)(colscale + col0 + bj * HALF + 4 * n); }
#pragma unroll
        for (int ai = 0; ai < 2; ++ai)
#pragma unroll
            for (int m = 0; m < 4; ++m) { const size_t ro = (size_t)(row0 + ai * HALF + m * 16) * DM + col0; float rs = 1.0f; if constexpr (I8) rs = rowscale[row0 + ai * HALF + m * 16];
#pragma unroll
                for (int bj = 0; bj < 2; ++bj) { f32x4 x0, x1;
                    if constexpr (XB) { const u32x4 xw = *(const u32x4*)((const bf16_t*)X + ro + bj * HALF); x0 = (f32x4){bflo(xw.x), bfhi(xw.x), bflo(xw.y), bfhi(xw.y)}; x1 = (f32x4){bflo(xw.z), bfhi(xw.z), bflo(xw.w), bfhi(xw.w)}; }
                    else { x0 = *(const f32x4*)((const float*)X + ro + bj * HALF); x1 = *(const f32x4*)((const float*)X + ro + bj * HALF + 4); }
                    f32x4 a0 = acc[ai][bj][m][0], a1 = acc[ai][bj][m][1];
                    if constexpr (I8) { const i32x4_t i0 = __builtin_bit_cast(i32x4_t, a0), i1 = __builtin_bit_cast(i32x4_t, a1);
                        a0 = (f32x4){(float)i0[0], (float)i0[1], (float)i0[2], (float)i0[3]} * rs; a1 = (f32x4){(float)i1[0], (float)i1[1], (float)i1[2], (float)i1[3]} * rs; }
                    const f32x4 r0 = x0 * ALPHA + gv[bj][0] * a0, r1 = x1 * ALPHA + gv[bj][1] * a1;
                    u32x4 w; w.x = cvt_pk_bf16(r0[0], r0[1]); w.y = cvt_pk_bf16(r0[2], r0[3]); w.z = cvt_pk_bf16(r1[0], r1[1]); w.w = cvt_pk_bf16(r1[2], r1[3]);
                    *(u32x4*)(U + ro + bj * HALF) = w; } }
    }
};
struct EpiI8Score {
    static constexpr bool PERM = true;
    bf16_t* O; int ldc; const float* rowscale; const float* colscale;
    __device__ __forceinline__ void operator()(const f32x4 (&acc)[2][2][4][2], const Unit& u, int wr, int wc, int fr, int fq) const {
        const int row0 = u.pm * BM + wr * 64 + fr, col0 = u.pn * BM + wc * 32 + 8 * fq;
        f32x4 sv[2][2];
#pragma unroll
        for (int bj = 0; bj < 2; ++bj)
#pragma unroll
            for (int n = 0; n < 2; ++n) sv[bj][n] = *(const f32x4*)(colscale + col0 + bj * HALF + 4 * n);
#pragma unroll
        for (int ai = 0; ai < 2; ++ai)
#pragma unroll
            for (int m = 0; m < 4; ++m) { const int row = row0 + ai * HALF + m * 16; const float rs = rowscale[row]; bf16_t* rowp = O + (size_t)row * ldc + col0;
#pragma unroll
                for (int bj = 0; bj < 2; ++bj) { const i32x4_t i0 = __builtin_bit_cast(i32x4_t, acc[ai][bj][m][0]), i1 = __builtin_bit_cast(i32x4_t, acc[ai][bj][m][1]);
                    const f32x4 s0 = sv[bj][0] * rs, s1 = sv[bj][1] * rs;
                    u32x4 w; w.x = cvt_pk_bf16((float)i0[0] * s0[0], (float)i0[1] * s0[1]); w.y = cvt_pk_bf16((float)i0[2] * s0[2], (float)i0[3] * s0[3]);
                    w.z = cvt_pk_bf16((float)i1[0] * s1[0], (float)i1[1] * s1[1]); w.w = cvt_pk_bf16((float)i1[2] * s1[2], (float)i1[3] * s1[3]);
                    *(u32x4*)(rowp + bj * HALF) = w; } }
    }
};
struct EpiBf16 {
    static constexpr bool PERM = true;
    bf16_t* O; int ldc; int coloff; const float* colscale;
    __device__ __forceinline__ void operator()(const f32x4 (&acc)[2][2][4][2], const Unit& u, int wr, int wc, int fr, int fq) const {
        const int row0 = u.pm * BM + wr * 64 + fr, col0 = u.pn * BM + wc * 32 + 8 * fq;
        f32x4 sv[2][2];
#pragma unroll
        for (int bj = 0; bj < 2; ++bj)
#pragma unroll
            for (int n = 0; n < 2; ++n) sv[bj][n] = colscale ? *(const f32x4*)(colscale + col0 + bj * HALF + 4 * n) : (f32x4){1.f, 1.f, 1.f, 1.f};
#pragma unroll
        for (int ai = 0; ai < 2; ++ai)
#pragma unroll
            for (int m = 0; m < 4; ++m) { bf16_t* rowp = O + (size_t)(row0 + ai * HALF + m * 16) * ldc + coloff + col0;
#pragma unroll
                for (int bj = 0; bj < 2; ++bj) { const f32x4 v0 = acc[ai][bj][m][0] * sv[bj][0], v1 = acc[ai][bj][m][1] * sv[bj][1];
                    u32x4 w; w.x = cvt_pk_bf16(v0[0], v0[1]); w.y = cvt_pk_bf16(v0[2], v0[3]); w.z = cvt_pk_bf16(v1[0], v1[1]); w.w = cvt_pk_bf16(v1[2], v1[3]);
                    *(u32x4*)(rowp + bj * HALF) = w; } }
    }
};

template <class Epi, class Ops, bool I8 = false>
__device__ __forceinline__ void gemm_phase(const int tid, LAS unsigned char* lds, const int K, const Ops& P, const StaticOrder& S, const Epi& E) {
    const int wid = __builtin_amdgcn_readfirstlane(tid >> 6), lane = tid & 63, wr = wid >> 2, wc = wid & 3, fr = lane & 15, fq = lane >> 4;
    const int nt = K / BK;
    unsigned voffA[2], voffB[2];
#pragma unroll
    for (int i = 0; i < 2; ++i) { int R, C; stage_rc(tid * 16 + i * 8192, R, C); const int Rb = Epi::PERM ? ((R & ~31) + perm32(R & 31)) : R;
        voffA[i] = (unsigned)(R * P.lda + C) * 2u; voffB[i] = (unsigned)(Rb * P.ldb + C) * 2u; }
    const size_t kstep = (size_t)(BK * 2);
    const size_t hstepA = (size_t)HALF * P.lda * 2, hstepB = (size_t)HALF * P.ldb * 2;
    const unsigned ldsw = (unsigned)wid * 1024u;
    const int aoff = lds_byte(wr * 64 + fr, fq * 8), boff = lds_byte(wc * 32 + fr, fq * 8);
#define PG8_SA(b, h) (((b) * 2 + (h)) * HTB)
#define PG8_SB(b, h) ((4 + (b) * 2 + (h)) * HTB)
#define PG8_STAGE(bufoff, gbase, voff) do { _Pragma("unroll") for (int _i = 0; _i < 2; ++_i) \
        __builtin_amdgcn_global_load_lds((const unsigned*)((const char*)(gbase) + (voff)[_i]), (LAS unsigned*)(lds + (bufoff) + ldsw + _i * 8192), 16, 0, 0); } while (0)
#define PG8_LDA(dst, b, h) do { _Pragma("unroll") for (int m = 0; m < 4; ++m) _Pragma("unroll") for (int k = 0; k < 2; ++k) dst[m][k] = *(const LAS bf16x8*)(lds + PG8_SA(b, h) + aoff + m * 2048 + k * 1024); } while (0)
#define PG8_LDB(dst, b, h) do { _Pragma("unroll") for (int n = 0; n < 2; ++n) _Pragma("unroll") for (int k = 0; k < 2; ++k) dst[n][k] = *(const LAS bf16x8*)(lds + PG8_SB(b, h) + boff + n * 2048 + k * 1024); } while (0)
#define PG8_MMA(ai, bj, At, Bt) do { __builtin_amdgcn_s_setprio(1); _Pragma("unroll") for (int m = 0; m < 4; ++m) _Pragma("unroll") for (int n = 0; n < 2; ++n) _Pragma("unroll") for (int k = 0; k < 2; ++k) \
        { if constexpr (I8) acc[ai][bj][m][n] = __builtin_bit_cast(f32x4, __builtin_amdgcn_mfma_i32_16x16x64_i8(__builtin_bit_cast(i32x4_t, Bt[n][k]), __builtin_bit_cast(i32x4_t, At[m][k]), __builtin_bit_cast(i32x4_t, acc[ai][bj][m][n]), 0, 0, 0)); \
          else acc[ai][bj][m][n] = __builtin_amdgcn_mfma_f32_16x16x32_bf16(Bt[n][k], At[m][k], acc[ai][bj][m][n], 0, 0, 0); } __builtin_amdgcn_s_setprio(0); } while (0)
#define PG8_WAIT_V(n) asm volatile("s_waitcnt vmcnt(" #n ")" ::: "memory")
#define PG8_WAIT_L(n) asm volatile("s_waitcnt lgkmcnt(" #n ")" ::: "memory")
#define PG8_BAR __builtin_amdgcn_s_barrier()
#define PG8_SCHED __builtin_amdgcn_sched_barrier(0)
    Unit cur, nxt; int ui = 0;
    if (!S.next(0, cur)) return;
    f32x4 acc[2][2][4][2];
#pragma unroll
    for (int a = 0; a < 2; ++a)
#pragma unroll
        for (int b = 0; b < 2; ++b)
#pragma unroll
            for (int m = 0; m < 4; ++m)
#pragma unroll
                for (int n = 0; n < 2; ++n) acc[a][b][m][n] = (f32x4){0.f, 0.f, 0.f, 0.f};
    bf16x8 At[4][2], B0[2][2], B1[2][2];
    const char* cA = P.a(cur); const char* cB = P.b(cur);
    PG8_STAGE(PG8_SB(0, 0), cB, voffB); PG8_STAGE(PG8_SA(0, 0), cA, voffA); PG8_STAGE(PG8_SB(0, 1), cB + hstepB, voffB); PG8_STAGE(PG8_SA(0, 1), cA + hstepA, voffA);
    if (wr == 1) PG8_BAR;
    PG8_WAIT_V(4); PG8_BAR;
    PG8_STAGE(PG8_SB(1, 0), cB + kstep, voffB); PG8_STAGE(PG8_SA(1, 0), cA + kstep, voffA); PG8_STAGE(PG8_SB(1, 1), cB + hstepB + kstep, voffB);
    PG8_WAIT_V(6); PG8_BAR;
    for (;;) {
        const bool has_next = S.next(ui + 1, nxt);
        const char* nA = has_next ? P.a(nxt) : cA; const char* nB = has_next ? P.b(nxt) : cB;
        for (int t = 0; t < nt; t += 2) {
            const bool last = (t == nt - 2);
            const char* a1 = cA + (size_t)(t + 1) * kstep;
            const char* a2 = last ? nA : cA + (size_t)(t + 2) * kstep; const char* b2 = last ? nB : cB + (size_t)(t + 2) * kstep;
            const char* a3 = a2 + kstep; const char* b3 = b2 + kstep;
            PG8_LDB(B0, 0, 0); PG8_SCHED; PG8_LDA(At, 0, 0); PG8_STAGE(PG8_SA(1, 1), a1 + hstepA, voffA);
            PG8_WAIT_L(8); PG8_BAR; PG8_WAIT_L(0); PG8_MMA(0, 0, At, B0); PG8_BAR; PG8_SCHED;
            PG8_LDB(B1, 0, 1); PG8_STAGE(PG8_SB(0, 0), b2, voffB);
            PG8_BAR; PG8_WAIT_L(0); PG8_MMA(0, 1, At, B1); PG8_BAR;
            PG8_LDA(At, 0, 1); PG8_STAGE(PG8_SA(0, 0), a2, voffA);
            PG8_BAR; PG8_WAIT_L(0); PG8_MMA(1, 0, At, B0); PG8_BAR; PG8_SCHED;
            PG8_STAGE(PG8_SB(0, 1), b2 + hstepB, voffB);
            PG8_WAIT_V(6); PG8_BAR; PG8_MMA(1, 1, At, B1); PG8_BAR;
            PG8_LDB(B0, 1, 0); PG8_SCHED; PG8_LDA(At, 1, 0); PG8_STAGE(PG8_SA(0, 1), a2 + hstepA, voffA);
            PG8_WAIT_L(8); PG8_BAR; PG8_WAIT_L(0); PG8_MMA(0, 0, At, B0); PG8_BAR; PG8_SCHED;
            PG8_LDB(B1, 1, 1); PG8_STAGE(PG8_SB(1, 0), b3, voffB);
            PG8_BAR; PG8_WAIT_L(0); PG8_MMA(0, 1, At, B1); PG8_BAR;
            PG8_LDA(At, 1, 1); PG8_STAGE(PG8_SA(1, 0), a3, voffA);
            PG8_BAR; PG8_WAIT_L(0); PG8_MMA(1, 0, At, B0); PG8_BAR; PG8_SCHED;
            PG8_STAGE(PG8_SB(1, 1), b3 + hstepB, voffB);
            PG8_WAIT_V(6); PG8_BAR; PG8_MMA(1, 1, At, B1); PG8_BAR;
        }
        E(acc, cur, wr, wc, fr, fq);
        if (!has_next) break;
#pragma unroll
        for (int a = 0; a < 2; ++a)
#pragma unroll
            for (int b = 0; b < 2; ++b)
#pragma unroll
                for (int m = 0; m < 4; ++m)
#pragma unroll
                    for (int n = 0; n < 2; ++n) acc[a][b][m][n] = (f32x4){0.f, 0.f, 0.f, 0.f};
        cur = nxt; cA = nA; cB = nB; ++ui;
    }
    PG8_WAIT_V(0);
    if (wr == 0) PG8_BAR;
    PG8_BAR;
#undef PG8_SA
#undef PG8_SB
#undef PG8_STAGE
#undef PG8_LDA
#undef PG8_LDB
#undef PG8_MMA
#undef PG8_WAIT_V
#undef PG8_WAIT_L
#undef PG8_BAR
#undef PG8_SCHED
}
}

namespace att {
constexpr int D = 128, NW = 8, QBLK = 32, KVBLK = 64;
constexpr float SCALE = ATT_SCALE;
constexpr float THR = 8.f;
constexpr int LDQ = ATT_IN, LDK = D, LDO = DM;
constexpr size_t SHM_V = KVBLK * D * 2, SHM_K = KVBLK * D * 2, SHM_ATTN = 2 * SHM_V + 2 * SHM_K + NW * 64 * 4;
#define KSWZ(row, colB) ((row) * 256 + ((colB) ^ (((row) & 7) << 4)))
#define SBAR() __builtin_amdgcn_sched_barrier(0)
__device__ __forceinline__ int crow(int r, int hi) { return (r & 3) + 8 * (r >> 2) + 4 * hi; }
__device__ __forceinline__ unsigned cvtpk(float lo, float hi) { unsigned r; asm volatile("v_cvt_pk_bf16_f32 %0, %1, %2" : "=v"(r) : "v"(lo), "v"(hi)); return r; }
__device__ __forceinline__ bf16x8 ld8(const bf16_t* p) { return *reinterpret_cast<const bf16x8*>(p); }

__device__ __forceinline__ void partialSM(f32x16& p0, f32x16& p1, float& m_reg, float& mn, float& alpha) {
  constexpr float C = SCALE * 1.4426950408889634f;
  float pmax = p0[0]; for (int r = 1; r < 16; ++r) pmax = fmaxf(pmax, p0[r]); for (int r = 0; r < 16; ++r) pmax = fmaxf(pmax, p1[r]);
  { auto rr = __builtin_amdgcn_permlane32_swap(__float_as_uint(pmax), __float_as_uint(pmax), false, false);
    pmax = fmaxf(__uint_as_float(rr[0]), __uint_as_float(rr[1])); }
  if (__builtin_expect(__all(pmax - m_reg <= THR / SCALE), 1)) { mn = m_reg; alpha = 1.f; }
  else { mn = fmaxf(m_reg, pmax); alpha = __builtin_amdgcn_exp2f((m_reg - mn) * C); m_reg = mn; }
  float mnC = -mn * C;
  for (int r = 0; r < 16; ++r) p0[r] = fmaf(p0[r], C, mnC); for (int r = 0; r < 16; ++r) p1[r] = fmaf(p1[r], C, mnC);
  for (int r = 0; r < 16; ++r) p0[r] = __builtin_amdgcn_exp2f(p0[r]);
}
__device__ __forceinline__ void finishSM(f32x16& p0, f32x16& p1, float alpha, float& l_reg, bf16x8& pa0, bf16x8& pa1, bf16x8& pa2, bf16x8& pa3) {
  for (int r = 0; r < 16; ++r) p1[r] = __builtin_amdgcn_exp2f(p1[r]);
  float ps = 0; for (int r = 0; r < 16; ++r) ps += p0[r]; for (int r = 0; r < 16; ++r) ps += p1[r];
  { auto rr = __builtin_amdgcn_permlane32_swap(__float_as_uint(ps), __float_as_uint(ps), false, false);
    ps = __uint_as_float(rr[0]) + __uint_as_float(rr[1]); }
  l_reg = l_reg * alpha + ps;
#define PK4(P, BASE, OUT) do { unsigned a0 = cvtpk(P[BASE + 0], P[BASE + 1]), a1 = cvtpk(P[BASE + 2], P[BASE + 3]);   \
    unsigned b0 = cvtpk(P[BASE + 4], P[BASE + 5]), b1 = cvtpk(P[BASE + 6], P[BASE + 7]);                              \
    auto r0 = __builtin_amdgcn_permlane32_swap(a0, b0, false, false); auto r1 = __builtin_amdgcn_permlane32_swap(a1, b1, false, false); \
    u32x4 w = {r0[0], r1[0], r0[1], r1[1]}; OUT = *reinterpret_cast<bf16x8*>(&w); } while (0)
  PK4(p0, 0, pa0); PK4(p0, 8, pa1); PK4(p1, 0, pa2); PK4(p1, 8, pa3);
#undef PK4
}
__device__ __forceinline__ void qkt(f32x16& p0, f32x16& p1, const bf16_t* Ks, const bf16x8* qr, int r32, int hi) {
  p0 = f32x16{}; p1 = f32x16{};
  for (int d0 = 0; d0 < 8; ++d0) { int cb = (d0 * 16 + hi * 8) * 2;
    bf16x8 b0 = *reinterpret_cast<const bf16x8*>((const char*)Ks + KSWZ(r32, cb));
    bf16x8 b1 = *reinterpret_cast<const bf16x8*>((const char*)Ks + KSWZ(32 + r32, cb));
    p0 = __builtin_amdgcn_mfma_f32_32x32x16_bf16(b0, qr[d0], p0, 0, 0, 0);
    p1 = __builtin_amdgcn_mfma_f32_32x32x16_bf16(b1, qr[d0], p1, 0, 0, 0); }
}
__device__ __forceinline__ int v_st(int k, int c) { const int kk = (k & ~0xC) | ((k & 4) << 1) | ((k & 8) >> 1); return ((kk >> 3) * 4 + (c >> 5)) * 512 + ((kk & 7) * 32 + (c & 31)) * 2; }
__device__ __forceinline__ int v_rd_base(int lane) { return ((lane & 3) << 3) | (((lane >> 2) & 3) << 6) | (((lane >> 4) & 1) << 5) | (((lane >> 5) & 1) << 8); }
constexpr int v_rd_off(int d0, int ks, int half) { return d0 * 512 + ks * 4096 + half * 2048; }
template <int OFF> __device__ __forceinline__ s16x4 tr_read(int vb) {
  s16x4 r; asm volatile("ds_read_b64_tr_b16 %0, %1 offset:%2" : "=&v"(r) : "v"(vb), "i"(OFF) : "memory"); return r;
}
template <int D0> __device__ __forceinline__ void pv_one(f32x16& od, int vb, bf16x8 pa0, bf16x8 pa1, bf16x8 pa2, bf16x8 pa3) {
  const s16x4 l0 = tr_read<v_rd_off(D0, 0, 0)>(vb), h0 = tr_read<v_rd_off(D0, 0, 1)>(vb), l1 = tr_read<v_rd_off(D0, 1, 0)>(vb), h1 = tr_read<v_rd_off(D0, 1, 1)>(vb);
  const s16x4 l2 = tr_read<v_rd_off(D0, 2, 0)>(vb), h2 = tr_read<v_rd_off(D0, 2, 1)>(vb), l3 = tr_read<v_rd_off(D0, 3, 0)>(vb), h3 = tr_read<v_rd_off(D0, 3, 1)>(vb);
  asm volatile("s_waitcnt lgkmcnt(0)" ::: "memory"); SBAR();
#define PK(L, H) (bf16x8){L[0], L[1], L[2], L[3], H[0], H[1], H[2], H[3]}
  od = __builtin_amdgcn_mfma_f32_32x32x16_bf16(pa0, PK(l0, h0), od, 0, 0, 0);
  od = __builtin_amdgcn_mfma_f32_32x32x16_bf16(pa1, PK(l1, h1), od, 0, 0, 0);
  od = __builtin_amdgcn_mfma_f32_32x32x16_bf16(pa2, PK(l2, h2), od, 0, 0, 0);
  od = __builtin_amdgcn_mfma_f32_32x32x16_bf16(pa3, PK(l3, h3), od, 0, 0, 0);
#undef PK
}
__device__ __forceinline__ void pv_d0(f32x16* o, int vb, bf16x8 pa0, bf16x8 pa1, bf16x8 pa2, bf16x8 pa3) {
  pv_one<0>(o[0], vb, pa0, pa1, pa2, pa3); pv_one<1>(o[1], vb, pa0, pa1, pa2, pa3); pv_one<2>(o[2], vb, pa0, pa1, pa2, pa3); pv_one<3>(o[3], vb, pa0, pa1, pa2, pa3);
}
__device__ __forceinline__ void attn_dense_body(const bf16_t* __restrict__ Qb, const bf16_t* __restrict__ Kh, const bf16_t* __restrict__ Vh,
                                                bf16_t* __restrict__ Ob, int seq, char* lds, const int tid) {
  const int wid = tid >> 6, lane = tid & 63, r32 = lane & 31, hi = lane >> 5;
  bf16_t* V_lds = (bf16_t*)lds; bf16_t* K_lds = (bf16_t*)(lds + 2 * SHM_V);
  float* ws = (float*)(lds + 2 * SHM_V + 2 * SHM_K) + wid * 64; float* li_l = ws; float* al_l = ws + 32;
  float m_reg = -1e30f, l_reg = 0; f32x16 o[4] = {}; bf16x8 qr[8];
  const bf16_t* Qw = Qb + (long)(wid * QBLK + r32) * LDQ + hi * 8;
#pragma unroll
  for (int d0 = 0; d0 < 8; ++d0) qr[d0] = ld8(Qw + d0 * 16);
  const int sr = tid >> 4, sc = (tid & 15) * 8, vst0 = v_st(sr, sc), vst1 = v_st(32 + sr, sc);
  const int vb0 = (int)(uintptr_t)V_lds + v_rd_base(lane);
  struct { bf16x8 vs0, vs1, ks0, ks1; } sr_[2];
#define SLOAD(i, k0) do { sr_[i].vs0 = ld8(&Vh[(long)((k0) + sr) * LDK + sc]); sr_[i].vs1 = ld8(&Vh[(long)((k0) + 32 + sr) * LDK + sc]); \
    sr_[i].ks0 = ld8(&Kh[(long)((k0) + sr) * LDK + sc]); sr_[i].ks1 = ld8(&Kh[(long)((k0) + 32 + sr) * LDK + sc]); } while (0)
#define SWRITE(b, i) do { *(bf16x8*)((char*)V_lds + (b) * SHM_V + vst0) = sr_[i].vs0;          \
    *(bf16x8*)((char*)V_lds + (b) * SHM_V + vst1) = sr_[i].vs1; int kc = sc * 2;               \
    *(bf16x8*)((char*)K_lds + (b) * SHM_K + KSWZ(sr, kc)) = sr_[i].ks0;                       \
    *(bf16x8*)((char*)K_lds + (b) * SHM_K + KSWZ(32 + sr, kc)) = sr_[i].ks1; } while (0)
#define SWAIT() asm volatile("s_waitcnt vmcnt(4)" ::: "memory")
#define RESC(a) do { if (__any((a) < 1.f)) { if (hi == 0) al_l[r32] = (a); asm volatile("s_waitcnt lgkmcnt(0)" ::: "memory"); \
    for (int d = 0; d < 4; ++d) for (int r = 0; r < 16; ++r) o[d][r] *= al_l[crow(r, hi)]; } } while (0)
  f32x16 pA0, pA1, pB0, pB1; float mnA, mnB, alA, alB; bf16x8 pa0, pa1, pa2, pa3; const int NT = seq / KVBLK;
  constexpr int SE = 0, SO = 1;
  SLOAD(SE, 0); asm volatile("s_waitcnt vmcnt(0)" ::: "memory"); SWRITE(0, SE); __syncthreads();
  qkt(pA0, pA1, K_lds, qr, r32, hi); partialSM(pA0, pA1, m_reg, mnA, alA);
  SLOAD(SO, KVBLK); if (2 < NT) SLOAD(SE, 2 * KVBLK);
  SWAIT(); SWRITE(1, SO); __syncthreads();
  for (int j = 1; j + 1 < NT; j += 2) {
    SBAR(); qkt(pB0, pB1, (bf16_t*)((char*)K_lds + SHM_K), qr, r32, hi);
    finishSM(pA0, pA1, alA, l_reg, pa0, pa1, pa2, pa3); SBAR();
    SLOAD(SO, (j + 2) * KVBLK); SBAR();
    pv_d0(o, vb0, pa0, pa1, pa2, pa3); partialSM(pB0, pB1, m_reg, mnB, alB);
    __syncthreads(); SWAIT(); SWRITE(0, SE);
    RESC(alB); __syncthreads();
    SBAR(); qkt(pA0, pA1, K_lds, qr, r32, hi);
    finishSM(pB0, pB1, alB, l_reg, pa0, pa1, pa2, pa3); SBAR();
    if (j + 3 < NT) SLOAD(SE, (j + 3) * KVBLK); SBAR();
    pv_d0(o, vb0 + (int)SHM_V, pa0, pa1, pa2, pa3); partialSM(pA0, pA1, m_reg, mnA, alA);
    __syncthreads(); SWAIT(); SWRITE(1, SO);
    RESC(alA); __syncthreads();
  }
  SBAR(); qkt(pB0, pB1, (bf16_t*)((char*)K_lds + SHM_K), qr, r32, hi);
  finishSM(pA0, pA1, alA, l_reg, pa0, pa1, pa2, pa3); SBAR();
  pv_d0(o, vb0, pa0, pa1, pa2, pa3); partialSM(pB0, pB1, m_reg, mnB, alB);
  __syncthreads(); RESC(alB);
  finishSM(pB0, pB1, alB, l_reg, pa0, pa1, pa2, pa3); SBAR();
  pv_d0(o, vb0 + (int)SHM_V, pa0, pa1, pa2, pa3);
  if (hi == 0) li_l[r32] = l_reg; asm volatile("s_waitcnt lgkmcnt(0)" ::: "memory");
  float rli[16];
#pragma unroll
  for (int r = 0; r < 16; ++r) rli[r] = __builtin_amdgcn_rcpf(li_l[crow(r, hi)]);
  bf16_t* Ow = Ob + (long)(wid * QBLK) * LDO;
#pragma unroll
  for (int r = 0; r < 16; ++r) { int orow = crow(r, hi);
#pragma unroll
    for (int d0 = 0; d0 < 4; ++d0) Ow[(long)orow * LDO + d0 * 32 + r32] = f2bf(o[d0][r] * rli[r]); }
  __syncthreads();
#undef SLOAD
#undef SWRITE
#undef SWAIT
#undef RESC
}
}

struct Ctx {
    LAS unsigned char* lds; int tid, lane, wave, G, bid;
};

__device__ __forceinline__ void transpose_job(const Ctx& F, const float* __restrict__ src, bf16_t* __restrict__ dst, int K, int N, int count) {
    LAS float* tile = (LAS float*)F.lds;
    const int tk = K / 64, tn = N / 128, per = tk * tn, total = count * per;
    const int lr = F.tid >> 5, c4 = (F.tid & 31) * 4;
    const int on = F.tid >> 2, ok = (F.tid & 3) * 16;
    f32x4 cur[4], nxt[4];
    int it = F.bid;
    if (it < total) { const int m = it / per, r = it % per, kt = r / tn, nt = r % tn; const float* s = src + (size_t)m * K * N + (size_t)(kt * 64 + lr) * N + nt * 128 + c4;
#pragma unroll
        for (int p = 0; p < 4; ++p) cur[p] = *(const f32x4*)(s + (size_t)p * 16 * N); }
    for (; it < total; it += F.G) {
        const int m = it / per, r = it % per, kt = r / tn, nt = r % tn;
        const int itn = it + F.G;
        if (itn < total) { const int m2 = itn / per, r2 = itn % per, kt2 = r2 / tn, nt2 = r2 % tn; const float* s = src + (size_t)m2 * K * N + (size_t)(kt2 * 64 + lr) * N + nt2 * 128 + c4;
#pragma unroll
            for (int p = 0; p < 4; ++p) nxt[p] = *(const f32x4*)(s + (size_t)p * 16 * N); }
#pragma unroll
        for (int p = 0; p < 4; ++p)
#pragma unroll
            for (int i = 0; i < 4; ++i) tile[(lr + 16 * p) * 129 + c4 + i] = cur[p][i];
        __syncthreads();
        float v[16];
#pragma unroll
        for (int i = 0; i < 16; ++i) v[i] = tile[(ok + i) * 129 + on];
        u32x4 w0, w1;
        w0.x = cvt_pk_bf16(v[0], v[1]); w0.y = cvt_pk_bf16(v[2], v[3]); w0.z = cvt_pk_bf16(v[4], v[5]); w0.w = cvt_pk_bf16(v[6], v[7]);
        w1.x = cvt_pk_bf16(v[8], v[9]); w1.y = cvt_pk_bf16(v[10], v[11]); w1.z = cvt_pk_bf16(v[12], v[13]); w1.w = cvt_pk_bf16(v[14], v[15]);
        bf16_t* d = dst + (size_t)m * K * N + (size_t)(nt * 128 + on) * K + kt * 64 + ok;
        *(u32x4*)d = w0; *(u32x4*)(d + 8) = w1;
        __syncthreads();
#pragma unroll
        for (int p = 0; p < 4; ++p) cur[p] = nxt[p];
    }
}

__device__ __forceinline__ void fourier_weights(const Ctx& F, const float* __restrict__ wf, bf16_t* __restrict__ fw) {
    LAS float* tab = (LAS float*)F.lds;
    if (F.tid < 256) { float s, c; sincospif((float)F.tid * (1.0f / 128.0f), &s, &c); tab[2 * F.tid] = c; tab[2 * F.tid + 1] = s; }
    __syncthreads();
    const int n = F.tid & 255, part = F.tid >> 8;
    for (int it = F.bid; it < 8 * 32; it += F.G) {
        const int ig = it >> 5, c0 = (it & 31) * 8;
        const float* w = wf + (size_t)ig * 65536 + n;
        float acc[8];
#pragma unroll
        for (int k = 0; k < 8; ++k) acc[k] = 0.f;
#pragma unroll 8
        for (int j = 0; j < 256; ++j) { const float wv = w[(size_t)j * 256];
#pragma unroll
            for (int k = 0; k < 8; ++k) acc[k] = fmaf(tab[2 * ((j * (c0 + k)) & 255) + part], wv, acc[k]); }
        const float sc = part ? -FOURIER_SCALE : FOURIER_SCALE;
        u32x4 o; o.x = cvt_pk_bf16(acc[0] * sc, acc[1] * sc); o.y = cvt_pk_bf16(acc[2] * sc, acc[3] * sc); o.z = cvt_pk_bf16(acc[4] * sc, acc[5] * sc); o.w = cvt_pk_bf16(acc[6] * sc, acc[7] * sc);
        *(u32x4*)(fw + ((size_t)(ig * 512 + part * 256 + n)) * 256 + c0) = o;
    }
    __syncthreads();
}

__device__ __forceinline__ void make_tables(const Ctx& F, float2* __restrict__ tw, float2* __restrict__ rope) {
    for (int idx = F.bid * NTHREADS + F.tid; idx < 8192 + 4096; idx += F.G * NTHREADS) {
        if (idx < 8192) { float s, c; sincospif((float)idx * (1.0f / 4096.0f), &s, &c); tw[idx] = make_float2(c, s); }
        else { const int j = idx - 8192, pos = j >> 5, i = j & 31; const float f = exp2f(-(float)i * 0.41524101186092034f); const float a = (float)pos * f;
            float s, c; sincosf(a, &s, &c); rope[j] = make_float2(c, s); }
    }
}

__device__ __forceinline__ void make_subkeys(const Ctx& F, const float* __restrict__ sk, bf16_t* __restrict__ dst) {
    for (int idx = F.bid * NTHREADS + F.tid; idx < 4 * 8 * 256 * 32; idx += F.G * NTHREADS) {
        const int kc = idx & 31, n1 = (idx >> 5) & 255, lh = idx >> 13;
        const int p = n1 >> 7, n = n1 & 127, pp = kc >> 4, d0 = (kc & 15) * 8;
        u32x4 w = {0u, 0u, 0u, 0u};
        if (p == pp) { const float* s = sk + ((size_t)(lh * 2 + p) * 128 + n) * 128 + d0; const f32x4 a = *(const f32x4*)s, b = *(const f32x4*)(s + 4);
            w.x = cvt_pk_bf16(a[0], a[1]); w.y = cvt_pk_bf16(a[2], a[3]); w.z = cvt_pk_bf16(b[0], b[1]); w.w = cvt_pk_bf16(b[2], b[3]); }
        *(u32x4*)(dst + (size_t)idx * 8) = w;
    }
}

__device__ __forceinline__ void adaln_partial(const Ctx& F, const float* __restrict__ cvec, const float* __restrict__ W, float* __restrict__ modp) {
    for (int it = F.bid; it < 8 * 3 * 32; it += F.G) {
        const int kc = it & 31, cc = (it >> 5) % 3, lj = it / 96;
        const int col = cc * 2048 + F.tid * 4;
        const float* w = W + (size_t)lj * 2048 * 6144 + (size_t)(kc * 64) * 6144 + col;
        f32x4 a0 = {0.f, 0.f, 0.f, 0.f}, a1 = {0.f, 0.f, 0.f, 0.f};
#pragma unroll 8
        for (int k = 0; k < 64; ++k) { const f32x4 wv = *(const f32x4*)(w + (size_t)k * 6144); const float c0 = cvec[kc * 64 + k], c1 = cvec[2048 + kc * 64 + k]; a0 += wv * c0; a1 += wv * c1; }
        float* o = modp + ((size_t)(lj * 32 + kc) * 2) * 6144 + col;
        *(f32x4*)o = a0; *(f32x4*)(o + 6144) = a1;
    }
}
__device__ __forceinline__ void adaln_reduce(const Ctx& F, const float* __restrict__ modp, const float* __restrict__ bias, float* __restrict__ mod) {
    for (int idx = F.bid * NTHREADS + F.tid; idx < 8 * 2 * 6144; idx += F.G * NTHREADS) {
        const int n = idx % 6144, b = (idx / 6144) & 1, lj = idx / 12288;
        float s = bias[lj * 6144 + n] + (n >= 4096 ? 1.0f : 0.0f);
        for (int kc = 0; kc < 32; ++kc) s += modp[((size_t)(lj * 32 + kc) * 2 + b) * 6144 + n];
        mod[idx] = s;
    }
}
__device__ __forceinline__ void cvt_stream(const Ctx& F, const float* __restrict__ src, bf16_t* __restrict__ dst, size_t n8) {
#pragma unroll 4
    for (size_t i = (size_t)F.bid * NTHREADS + F.tid; i < n8; i += (size_t)F.G * NTHREADS) {
        const f32x4 a = *(const f32x4*)(src + i * 8), b = *(const f32x4*)(src + i * 8 + 4);
        u32x4 w; w.x = cvt_pk_bf16(a[0], a[1]); w.y = cvt_pk_bf16(a[2], a[3]); w.z = cvt_pk_bf16(b[0], b[1]); w.w = cvt_pk_bf16(b[2], b[3]);
        *(u32x4*)(dst + i * 8) = w;
    }
}

__device__ __forceinline__ void row_load_f32(const float* __restrict__ row, int lane, float (&v)[32]) {
#pragma unroll
    for (int c = 0; c < 4; ++c) { const f32x4 a = *(const f32x4*)(row + c * 512 + lane * 8), b = *(const f32x4*)(row + c * 512 + lane * 8 + 4);
#pragma unroll
        for (int i = 0; i < 4; ++i) { v[c * 8 + i] = a[i]; v[c * 8 + 4 + i] = b[i]; } }
}
__device__ __forceinline__ void row_load_bf16(const bf16_t* __restrict__ row, int lane, float (&v)[32]) {
#pragma unroll
    for (int c = 0; c < 4; ++c) { const u32x4 w = *(const u32x4*)(row + c * 512 + lane * 8);
        v[c * 8 + 0] = bflo(w.x); v[c * 8 + 1] = bfhi(w.x); v[c * 8 + 2] = bflo(w.y); v[c * 8 + 3] = bfhi(w.y); v[c * 8 + 4] = bflo(w.z); v[c * 8 + 5] = bfhi(w.z); v[c * 8 + 6] = bflo(w.w); v[c * 8 + 7] = bfhi(w.w); }
}
__device__ __forceinline__ void row_store_f32(float* __restrict__ row, int lane, const float (&v)[32]) {
#pragma unroll
    for (int c = 0; c < 4; ++c) { f32x4 a, b;
#pragma unroll
        for (int i = 0; i < 4; ++i) { a[i] = v[c * 8 + i]; b[i] = v[c * 8 + 4 + i]; }
        *(f32x4*)(row + c * 512 + lane * 8) = a; *(f32x4*)(row + c * 512 + lane * 8 + 4) = b; }
}
__device__ __forceinline__ void row_store_bf16(bf16_t* __restrict__ row, int lane, const float (&v)[32]) {
#pragma unroll
    for (int c = 0; c < 4; ++c) { u32x4 w; w.x = cvt_pk_bf16(v[c * 8 + 0], v[c * 8 + 1]); w.y = cvt_pk_bf16(v[c * 8 + 2], v[c * 8 + 3]); w.z = cvt_pk_bf16(v[c * 8 + 4], v[c * 8 + 5]); w.w = cvt_pk_bf16(v[c * 8 + 6], v[c * 8 + 7]);
        *(u32x4*)(row + c * 512 + lane * 8) = w; }
}
__device__ __forceinline__ void row_store_i8(signed char* __restrict__ row, float* __restrict__ scale, int lane, const float (&v)[32]) {
    float m = 0.f;
#pragma unroll
    for (int i = 0; i < 32; ++i) m = fmaxf(m, fabsf(v[i]));
    m = fmaxf(wave_max(m), 1e-30f);
    const float inv = 127.0f / m;
#pragma unroll
    for (int d = 0; d < 4; ++d) { unsigned b0 = 0u, b1 = 0u;
#pragma unroll
        for (int k = 0; k < 4; ++k) { b0 = __builtin_amdgcn_cvt_pk_u8_f32(rintf(fmaf(v[d * 8 + k], inv, 128.0f)), k, b0); b1 = __builtin_amdgcn_cvt_pk_u8_f32(rintf(fmaf(v[d * 8 + 4 + k], inv, 128.0f)), k, b1); }
        *(u32x2*)(row + d * 512 + lane * 8) = (u32x2){b0 ^ 0x80808080u, b1 ^ 0x80808080u}; }
    if (lane == 0) *scale = m * (1.0f / 127.0f);
}
__device__ __forceinline__ void row_norm(float (&v)[32]) {
    float s = 0.f;
#pragma unroll
    for (int i = 0; i < 32; ++i) s += v[i];
    const float mu = wave_sum(s) * (1.0f / 2048.0f);
    float q = 0.f;
#pragma unroll
    for (int i = 0; i < 32; ++i) { v[i] -= mu; q = fmaf(v[i], v[i], q); }
    const float rstd = rsqrtf(wave_sum(q) * (1.0f / 2048.0f) + LN_EPS);
#pragma unroll
    for (int i = 0; i < 32; ++i) v[i] *= rstd;
}
__device__ __forceinline__ void row_norm_ms(float (&v)[32], float& mu_out, float& rstd_out) {
    float s = 0.f;
#pragma unroll
    for (int i = 0; i < 32; ++i) s += v[i];
    const float mu = wave_sum(s) * (1.0f / 2048.0f);
    float q = 0.f;
#pragma unroll
    for (int i = 0; i < 32; ++i) { v[i] -= mu; q = fmaf(v[i], v[i], q); }
    const float rstd = rsqrtf(wave_sum(q) * (1.0f / 2048.0f) + LN_EPS);
#pragma unroll
    for (int i = 0; i < 32; ++i) v[i] *= rstd;
    mu_out = mu; rstd_out = rstd;
}
__device__ __forceinline__ void row_modulate(float (&v)[32], const float* __restrict__ modrow, int lane) {
    float sh[32], sc[32]; row_load_f32(modrow, lane, sh); row_load_f32(modrow + 2048, lane, sc);
#pragma unroll
    for (int i = 0; i < 32; ++i) v[i] = fmaf(v[i], 1.0f + sc[i], sh[i]);
}
__device__ __forceinline__ void row_affine(float (&v)[32], const float* __restrict__ g, const float* __restrict__ b, int lane) {
    float gg[32], bb[32]; row_load_f32(g, lane, gg); row_load_f32(b, lane, bb);
#pragma unroll
    for (int i = 0; i < 32; ++i) v[i] = fmaf(v[i], gg[i], bb[i]);
}

__device__ __forceinline__ void lds_copy_vec(const Ctx& F, LAS float* dst, const float* __restrict__ src, int n) { for (int i = F.tid * 4; i < n; i += NTHREADS * 4) *(LAS f32x4*)(dst + i) = *(const f32x4*)(src + i); }
__device__ __forceinline__ void row_load_lds(const LAS float* row, int lane, float (&v)[32]) {
#pragma unroll
    for (int c = 0; c < 4; ++c) { const f32x4 a = *(const LAS f32x4*)(row + c * 512 + lane * 8), b = *(const LAS f32x4*)(row + c * 512 + lane * 8 + 4);
#pragma unroll
        for (int i = 0; i < 4; ++i) { v[c * 8 + i] = a[i]; v[c * 8 + 4 + i] = b[i]; } }
}
__device__ __forceinline__ void row_modulate_lds(float (&v)[32], const LAS float* shift, const LAS float* scale, int lane) {
    float sh[32], sc[32]; row_load_lds(shift, lane, sh); row_load_lds(scale, lane, sc);
#pragma unroll
    for (int i = 0; i < 32; ++i) v[i] = fmaf(v[i], 1.0f + sc[i], sh[i]);
}
__device__ __forceinline__ void row_affine_lds(float (&v)[32], const LAS float* g, const LAS float* b, int lane) {
    float gg[32], bb[32]; row_load_lds(g, lane, gg); row_load_lds(b, lane, bb);
#pragma unroll
    for (int i = 0; i < 32; ++i) v[i] = fmaf(v[i], gg[i], bb[i]);
}

__device__ __forceinline__ void quant_wsc_rows(const Ctx& F, const bf16_t* __restrict__ w, signed char* __restrict__ w8, float* __restrict__ wscale, int nrows) {
    for (int r = F.bid * NWAVES + F.wave; r < nrows; r += F.G * NWAVES) {
        float v[32]; row_load_bf16(w + (size_t)r * DM, F.lane, v);
        float m = 0.f;
#pragma unroll
        for (int i = 0; i < 32; ++i) m = fmaxf(m, fabsf(v[i]));
        m = fmaxf(wave_max(m), 1e-30f);
        const float inv = 127.0f / m;
#pragma unroll
        for (int d = 0; d < 4; ++d) { unsigned b0 = 0u, b1 = 0u;
#pragma unroll
            for (int k = 0; k < 4; ++k) { b0 = __builtin_amdgcn_cvt_pk_u8_f32(rintf(fmaf(v[d * 8 + k], inv, 128.0f)), k, b0); b1 = __builtin_amdgcn_cvt_pk_u8_f32(rintf(fmaf(v[d * 8 + 4 + k], inv, 128.0f)), k, b1); }
            *(u32x2*)(w8 + (size_t)r * DM + d * 512 + F.lane * 8) = (u32x2){b0 ^ 0x80808080u, b1 ^ 0x80808080u}; }
        if (F.lane == 0) wscale[r] = m * (1.0f / 127.0f);
    }
}
__device__ __forceinline__ void quant_rows_phase(const Ctx& F, const bf16_t* __restrict__ y, signed char* __restrict__ y8, float* __restrict__ ysc) {
    for (int t = F.bid * NWAVES + F.wave; t < NTOK; t += F.G * NWAVES) { float v[32]; row_load_bf16(y + (size_t)t * DM, F.lane, v); row_store_i8(y8 + (size_t)t * DM, ysc + t, F.lane, v); }
}
__device__ __forceinline__ void ln_mod_phase(const Ctx& F, const float* __restrict__ x, const float* __restrict__ modlj, signed char* __restrict__ h8i, float* __restrict__ hsc) {
    for (int t = F.bid * NWAVES + F.wave; t < NTOK; t += F.G * NWAVES) {
        float v[32]; row_load_f32(x + (size_t)t * DM, F.lane, v);
        row_norm(v); row_modulate(v, modlj + (size_t)(t / SEQ) * 6144, F.lane);
        row_store_i8(h8i + (size_t)t * DM, hsc + t, F.lane, v);
    }
}
__device__ __forceinline__ void ln2_phase(const Ctx& F, const bf16_t* __restrict__ u, const float* __restrict__ g, const float* __restrict__ b, const float* __restrict__ modlj,
                                          signed char* __restrict__ h8i  , unsigned char* __restrict__ h8, float* __restrict__ hs, float* __restrict__ lns  ) {
    LAS float* lv = (LAS float*)F.lds;
    lds_copy_vec(F, lv, g, 2048); lds_copy_vec(F, lv + 2048, b, 2048); lds_copy_vec(F, lv + 4096, modlj, 4096); lds_copy_vec(F, lv + 8192, modlj + 6144, 4096);
    __syncthreads();
    for (int t = F.bid * NWAVES + F.wave; t < NTOK; t += F.G * NWAVES) {
        float v[32]; row_load_bf16(u + (size_t)t * DM, F.lane, v);
        float mu0, rstd0; row_norm_ms(v, mu0, rstd0); row_affine_lds(v, lv, lv + 2048, F.lane);
        if (F.lane == 0) { lns[2 * t] = mu0; lns[2 * t + 1] = rstd0; }
        { const LAS float* mr = lv + 4096 + (t / SEQ) * 4096; row_norm(v); row_modulate_lds(v, mr, mr + 2048, F.lane); }
        float m = 0.f;
#pragma unroll
        for (int i = 0; i < 32; ++i) m = fmaxf(m, fabsf(v[i]));
        m = fmaxf(wave_max(m), 1e-20f);
        const float inv = 119.0f / m;
        { unsigned wh[4], wl[4];
#pragma unroll
          for (int d = 0; d < 4; ++d) { unsigned b0 = 0u, b1 = 0u;
#pragma unroll
              for (int k = 0; k < 4; ++k) { b0 = __builtin_amdgcn_cvt_pk_u8_f32(rintf(fmaf(v[d * 8 + k], inv, 136.0f)), k, b0); b1 = __builtin_amdgcn_cvt_pk_u8_f32(rintf(fmaf(v[d * 8 + 4 + k], inv, 136.0f)), k, b1); }
              { const unsigned s0_ = ((b0 & 0x7F7F7F7Fu) + 0x78787878u) ^ ((b0 ^ 0x78787878u) & 0x80808080u), s1_ = ((b1 & 0x7F7F7F7Fu) + 0x78787878u) ^ ((b1 ^ 0x78787878u) & 0x80808080u);
                *(u32x2*)(h8i + (size_t)t * DM + d * 512 + F.lane * 8) = (u32x2){s0_, s1_}; }
              b0 ^= 0x88888888u; b1 ^= 0x88888888u;
              wh[d] = (b0 & 0xF0F0F0F0u) | ((b1 >> 4) & 0x0F0F0F0Fu);
              wl[d] = ((b0 << 4) & 0xF0F0F0F0u) | (b1 & 0x0F0F0F0Fu); }
          *(u32x4*)(h8 + (size_t)t * DM + F.lane * 16) = (u32x4){wh[0], wh[1], wh[2], wh[3]};
          *(u32x4*)(h8 + (size_t)t * DM + 1024 + F.lane * 16) = (u32x4){wl[0], wl[1], wl[2], wl[3]}; }
        if (F.lane == 0) hs[t] = m * (1.0f / 119.0f);
    }
    __syncthreads();
}

template <bool SGN  >
__device__ __forceinline__ void quant4_rows(const Ctx& F, const float* __restrict__ src, unsigned char* __restrict__ dst, bf16_t* __restrict__ scl, int nrows) {
    float v[32], nx[32];
    int r = F.bid * NWAVES + F.wave;
    if (r < nrows) row_load_f32(src + (size_t)r * DM, F.lane, v);
    for (; r < nrows; r += F.G * NWAVES) {
        const int rn = r + F.G * NWAVES;
        if (rn < nrows) row_load_f32(src + (size_t)rn * DM, F.lane, nx);
        float m = 0.f;
#pragma unroll
        for (int i = 0; i < 32; ++i) m = fmaxf(m, fabsf(v[i]));
        m = fmaxf(m, DPPF(m, 0xB1));
        const bf16_t sb = f2bf(fmaxf(m, 1e-30f) * (1.0f / 7.0f));
        const float inv = 1.0f / bf2f(sb);
        unsigned w[4];
#pragma unroll
        for (int d = 0; d < 4; ++d) { unsigned x = 0u;
#pragma unroll
            for (int k = 0; k < 8; ++k) { int q = (int)rintf(v[d * 8 + k] * inv); q = min(max(q, -7), 7);
                if (SGN) x |= ((unsigned)q & 15u) << ((k < 4) ? 8 * k + 4 : 8 * (k - 4)); else x |= (unsigned)(q + 8) << (4 * k); }
            w[d] = x; }
        const size_t srow = ((size_t)((r >> 14) * 8 + (F.lane >> 3)) * NEXP + (r & (NEXP - 1)));
        *(u32x4*)(dst + srow * 128 + (F.lane & 7) * 16) = (u32x4){w[0], w[1], w[2], w[3]};
        if ((F.lane & 1) == 0) scl[srow * 4 + ((F.lane & 7) >> 1)] = sb;
#pragma unroll
        for (int i = 0; i < 32; ++i) v[i] = nx[i];
    }
}

__device__ __forceinline__ void quant_fp4_rows(const Ctx& F, const float* __restrict__ src, unsigned char* __restrict__ dst, bf16_t* __restrict__ scl, int nrows) {
    f32x4 v[8], nx[8];
    int r = F.bid * NWAVES + F.wave;
    if (r < nrows) {
#pragma unroll
        for (int i = 0; i < 8; ++i) v[i] = *(const f32x4*)(src + (size_t)r * DM + F.lane * 32 + i * 4); }
    for (; r < nrows; r += F.G * NWAVES) {
        const int rn = r + F.G * NWAVES;
        if (rn < nrows) {
#pragma unroll
            for (int i = 0; i < 8; ++i) nx[i] = *(const f32x4*)(src + (size_t)rn * DM + F.lane * 32 + i * 4); }
        float m = 0.f;
#pragma unroll
        for (int i = 0; i < 8; ++i) m = fmaxf(fmaxf(m, fmaxf(fabsf(v[i][0]), fabsf(v[i][1]))), fmaxf(fabsf(v[i][2]), fabsf(v[i][3])));
        m = fmaxf(m, DPPF(m, 0xB1)); m = fmaxf(m, DPPF(m, 0x4E)); m = fmaxf(m, DPPF(m, 0x141));
        const bf16_t sb = f2bf(fmaxf(m, 1e-30f) * (1.0f / 6.0f));
        const float inv = 1.0f / bf2f(sb);
        unsigned hw[8];
#pragma unroll
        for (int j = 0; j < 8; ++j) hw[j] = 0u;
#pragma unroll
        for (int qq = 0; qq < 32; ++qq) {
            const float y = v[qq >> 2][qq & 3] * inv; const float a = fminf(fabsf(y), 6.0f);
            const float f = a < 2.0f ? 2.0f : (a < 4.0f ? 1.0f : 0.5f); const int off = a < 2.0f ? 0 : (a < 4.0f ? 2 : 4);
            const unsigned code = (unsigned)((int)rintf(a * f) + off) | (y < 0.f ? 8u : 0u);
            hw[((qq >> 2) & 1) * 4 + (qq & 3)] |= code << (4 * (qq >> 3)); }
        const int L = r >> 14, e = r & (NEXP - 1), xs = F.lane >> 3, kq = (F.lane >> 1) & 3, odd = F.lane & 1;
        const size_t srow = (size_t)(L * 8 + xs) * NEXP + e;
        unsigned* row = (unsigned*)(dst + srow * 128);
#pragma unroll
        for (int rr = 0; rr < 4; ++rr) {
            const unsigned mine = odd ? hw[4 + rr] : hw[rr], other = odd ? hw[rr] : hw[4 + rr];
            const unsigned got = (unsigned)__builtin_amdgcn_update_dpp(0, (int)other, 0xB1, 0xF, 0xF, true);
            row[(4 * kq + rr) * 2 + odd] = odd ? (got | (mine << 16)) : (mine | (got << 16)); }
        if ((F.lane & 7) == 0) scl[((size_t)L * NEXP + e) * 8 + xs] = sb;
#pragma unroll
        for (int i = 0; i < 8; ++i) v[i] = nx[i];
    }
}

__device__ __forceinline__ void pool_phase(const Ctx& F, const bf16_t* __restrict__ zb, bf16_t* __restrict__ pb) {
    const int ch = F.tid & 127, tq = F.tid >> 7, g = ch >> 5, half = 1 << g;
    __syncthreads();
    for (int it = F.bid; it < NTOK / 32; it += F.G) {
        const int t0 = it * 32, s0 = t0 & (SEQ - 1), tb = t0 - s0, rbase = s0 - 8;
#pragma unroll
        for (int k = 0; k < 12; ++k) { const int id = k * NTHREADS + F.tid, row = id >> 7, c16 = id & 127, s = rbase + row;
            if (s >= 0 && s < SEQ) *(LAS u32x4*)(F.lds + row * 2048 + c16 * 16) = *(const u32x4*)(zb + (size_t)(tb + s) * DM + 1024 + c16 * 8); }
        __syncthreads();
        const LAS unsigned char* col = F.lds + ch * 16;
#define POOL_ROW(r) (*(const LAS u32x4*)(col + ((r) - rbase) * 2048))
#define POOL_ACC(V_, sgn) do { acc[0] += sgn bflo(V_.x); acc[1] += sgn bfhi(V_.x); acc[2] += sgn bflo(V_.y); acc[3] += sgn bfhi(V_.y); acc[4] += sgn bflo(V_.z); acc[5] += sgn bfhi(V_.z); acc[6] += sgn bflo(V_.w); acc[7] += sgn bfhi(V_.w); } while (0)
        const int sa = s0 + tq * 8;
        float acc[8];
#pragma unroll
        for (int i = 0; i < 8; ++i) acc[i] = 0.f;
        for (int r = max(sa - half, 0); r < min(sa + half, SEQ); ++r) { const u32x4 w = POOL_ROW(r); POOL_ACC(w, +); }
#pragma unroll
        for (int k = 0; k < 8; ++k) {
            const int s = sa + k, lo = max(s - half, 0), hi = min(s + half, SEQ);
            const u32x4 zc = POOL_ROW(s);
            const float inv = 1.0f / (float)(hi - lo);
            float o[8];
            o[0] = acc[0] * inv - bflo(zc.x); o[1] = acc[1] * inv - bfhi(zc.x); o[2] = acc[2] * inv - bflo(zc.y); o[3] = acc[3] * inv - bfhi(zc.y);
            o[4] = acc[4] * inv - bflo(zc.z); o[5] = acc[5] * inv - bfhi(zc.z); o[6] = acc[6] * inv - bflo(zc.w); o[7] = acc[7] * inv - bfhi(zc.w);
            u32x4 w; w.x = cvt_pk_bf16(o[0], o[1]); w.y = cvt_pk_bf16(o[2], o[3]); w.z = cvt_pk_bf16(o[4], o[5]); w.w = cvt_pk_bf16(o[6], o[7]);
            *(u32x4*)(pb + (size_t)(tb + s) * 1024 + ch * 8) = w;
            if (s + half < SEQ) { const u32x4 wn = POOL_ROW(s + half); POOL_ACC(wn, +); }
            if (s - half >= 0) { const u32x4 wo = POOL_ROW(s - half); POOL_ACC(wo, -); }
        }
#undef POOL_ROW
#undef POOL_ACC
        __syncthreads();
    }
}
__device__ __forceinline__ int crow32(int r, int hi) { return (r & 3) + 8 * (r >> 2) + 4 * hi; }

template <int OFF> __device__ __forceinline__ s16x4 dft_tr(int addr) { s16x4 r; asm volatile("ds_read_b64_tr_b16 %0, %1 offset:%2" : "=&v"(r) : "v"(addr), "i"(OFF) : "memory"); return r; }
__device__ __forceinline__ void dft1_phase(const Ctx& F, const bf16_t* __restrict__ pq, const float2* __restrict__ tw, bf16_t* __restrict__ yr, bf16_t* __restrict__ yi) {
    LAS unsigned char* tab = F.lds;
    for (int e = F.tid; e < 4 * 8 * 64; e += NTHREADS) {
        const int ln = e & 63, ks = (e >> 6) & 7, mb = e >> 9, m = mb * 32 + (ln & 31), po = m >> 6, k1 = m & 63;
        float v[8];
#pragma unroll
        for (int j = 0; j < 8; ++j) { const int k = ks * 16 + 8 * (ln >> 5) + j, pi = k >> 6, s1 = k & 63; float s, c; sincospif((float)((k1 * s1) & 63) * (1.0f / 32.0f), &s, &c);
            v[j] = (po == pi) ? c : (po == 0 ? s : -s); }
        u32x4 w; w.x = cvt_pk_bf16(v[0], v[1]); w.y = cvt_pk_bf16(v[2], v[3]); w.z = cvt_pk_bf16(v[4], v[5]); w.w = cvt_pk_bf16(v[6], v[7]);
        *(LAS u32x4*)(tab + (size_t)e * 16) = w;
    }
    __syncthreads();
    LAS unsigned char* tile = F.lds + 32768 + F.wave * 8192;
    const int l31 = F.lane & 31, hh = F.lane >> 5, i16 = F.lane & 15, g1 = (F.lane >> 4) & 1;
    const int trb = (int)(uintptr_t)tile + (8 * hh + (i16 >> 2)) * 64 + g1 * 32 + (i16 & 3) * 8;
    for (int it = F.bid * NWAVES + F.wave; it < 2 * 128 * 32; it += F.G * NWAVES) {
        const int nb = it & 31, s2 = (it >> 5) & 127, b = it >> 12;
        const int n0 = nb * 32, g = n0 >> 8, d0 = n0 & 255;
        u32x4 v[8];
#pragma unroll
        for (int i = 0; i < 8; ++i) { const int c = F.lane + 64 * i, k = c >> 2, seg = c & 3;
            v[i] = *(const u32x4*)(pq + ((size_t)b * SEQ + 128 * (k & 63) + s2) * DM + g * 512 + (k >> 6) * 256 + d0 + seg * 8); }
        asm volatile("s_waitcnt lgkmcnt(0)" ::: "memory");
#pragma unroll
        for (int i = 0; i < 8; ++i) { const int c = F.lane + 64 * i; *(LAS u32x4*)(tile + (c >> 2) * 64 + (c & 3) * 16) = v[i]; }
        asm volatile("s_waitcnt lgkmcnt(0)" ::: "memory");
        f32x16 acc[4] = {};
        { s16x4 blo[8], bhi[8];
          blo[0] = dft_tr<0 * 1024>(trb); bhi[0] = dft_tr<0 * 1024 + 256>(trb); blo[1] = dft_tr<1 * 1024>(trb); bhi[1] = dft_tr<1 * 1024 + 256>(trb);
          blo[2] = dft_tr<2 * 1024>(trb); bhi[2] = dft_tr<2 * 1024 + 256>(trb); blo[3] = dft_tr<3 * 1024>(trb); bhi[3] = dft_tr<3 * 1024 + 256>(trb);
          blo[4] = dft_tr<4 * 1024>(trb); bhi[4] = dft_tr<4 * 1024 + 256>(trb); blo[5] = dft_tr<5 * 1024>(trb); bhi[5] = dft_tr<5 * 1024 + 256>(trb);
          blo[6] = dft_tr<6 * 1024>(trb); bhi[6] = dft_tr<6 * 1024 + 256>(trb); blo[7] = dft_tr<7 * 1024>(trb); bhi[7] = dft_tr<7 * 1024 + 256>(trb);
          asm volatile("s_waitcnt lgkmcnt(0)" ::: "memory"); __builtin_amdgcn_sched_barrier(0);
#pragma unroll
          for (int ks = 0; ks < 8; ++ks) {
              const bf16x8 bfr = {blo[ks][0], blo[ks][1], blo[ks][2], blo[ks][3], bhi[ks][0], bhi[ks][1], bhi[ks][2], bhi[ks][3]};
#pragma unroll
              for (int mb = 0; mb < 4; ++mb) { const bf16x8 af = *(const LAS bf16x8*)(tab + ((size_t)((mb * 8 + ks) * 64 + F.lane)) * 16);
                  acc[mb] = __builtin_amdgcn_mfma_f32_32x32x16_bf16(af, bfr, acc[mb], 0, 0, 0); }
          }
          __builtin_amdgcn_sched_barrier(0); }
        const int n = n0 + l31;
#pragma unroll
        for (int kb = 0; kb < 2; ++kb)
#pragma unroll
            for (int r = 0; r < 16; ++r) {
                const int k1 = kb * 32 + crow32(r, hh);
                const float2 t = tw[k1 * s2];
                const float a = acc[kb][r], bb = acc[2 + kb][r];
                const size_t o = (((size_t)b * 64 + k1) * 128 + s2) * 1024 + n;
                yr[o] = f2bf(a * t.x + bb * t.y); yi[o] = f2bf(bb * t.x - a * t.y);
            }
    }
    __syncthreads();
}
__device__ __forceinline__ void dft2_phase(const Ctx& F, const bf16_t* __restrict__ yr, const bf16_t* __restrict__ yi, bf16_t* __restrict__ ymix) {
    LAS unsigned char* tab = F.lds;
    for (int e = F.tid; e < 4 * 16 * 64; e += NTHREADS) {
        const int ln = e & 63, ks = (e >> 6) & 15, mb = e >> 10, k2 = mb * 32 + (ln & 31);
        float v[8];
#pragma unroll
        for (int j = 0; j < 8; ++j) { const int k = ks * 16 + 8 * (ln >> 5) + j, part = k >> 7, s2 = k & 127; float s, c; sincospif((float)((k2 * s2) & 127) * (1.0f / 64.0f), &s, &c);
            v[j] = part ? s : c; }
        u32x4 w; w.x = cvt_pk_bf16(v[0], v[1]); w.y = cvt_pk_bf16(v[2], v[3]); w.z = cvt_pk_bf16(v[4], v[5]); w.w = cvt_pk_bf16(v[6], v[7]);
        *(LAS u32x4*)(tab + (size_t)e * 16) = w;
    }
    __syncthreads();
    LAS unsigned char* tile = F.lds + 65536 + F.wave * 8192;
    const int l31 = F.lane & 31, hh = F.lane >> 5, i16 = F.lane & 15, g1 = (F.lane >> 4) & 1;
    const int trb = (int)(uintptr_t)tile + (8 * hh + (i16 >> 2)) * 64 + g1 * 32 + (i16 & 3) * 8;
    for (int it = F.bid * NWAVES + F.wave; it < 2 * 64 * 32; it += F.G * NWAVES) {
        const int nb = it & 31, k1 = (it >> 5) & 63, b = it >> 11;
        const int n0 = nb * 32;
        f32x16 acc[4] = {};
#pragma unroll
        for (int plane = 0; plane < 2; ++plane) {
            const bf16_t* src = (plane ? yi : yr) + (((size_t)b * 64 + k1) * 128) * 1024 + n0;
            u32x4 v[8];
#pragma unroll
            for (int i = 0; i < 8; ++i) { const int c = F.lane + 64 * i; v[i] = *(const u32x4*)(src + (size_t)(c >> 2) * 1024 + (c & 3) * 8); }
            asm volatile("s_waitcnt lgkmcnt(0)" ::: "memory");
#pragma unroll
            for (int i = 0; i < 8; ++i) { const int c = F.lane + 64 * i; *(LAS u32x4*)(tile + (c >> 2) * 64 + (c & 3) * 16) = v[i]; }
            asm volatile("s_waitcnt lgkmcnt(0)" ::: "memory");
            s16x4 blo[8], bhi[8];
            blo[0] = dft_tr<0 * 1024>(trb); bhi[0] = dft_tr<0 * 1024 + 256>(trb); blo[1] = dft_tr<1 * 1024>(trb); bhi[1] = dft_tr<1 * 1024 + 256>(trb);
            blo[2] = dft_tr<2 * 1024>(trb); bhi[2] = dft_tr<2 * 1024 + 256>(trb); blo[3] = dft_tr<3 * 1024>(trb); bhi[3] = dft_tr<3 * 1024 + 256>(trb);
            blo[4] = dft_tr<4 * 1024>(trb); bhi[4] = dft_tr<4 * 1024 + 256>(trb); blo[5] = dft_tr<5 * 1024>(trb); bhi[5] = dft_tr<5 * 1024 + 256>(trb);
            blo[6] = dft_tr<6 * 1024>(trb); bhi[6] = dft_tr<6 * 1024 + 256>(trb); blo[7] = dft_tr<7 * 1024>(trb); bhi[7] = dft_tr<7 * 1024 + 256>(trb);
            asm volatile("s_waitcnt lgkmcnt(0)" ::: "memory"); __builtin_amdgcn_sched_barrier(0);
#pragma unroll
            for (int ks = 0; ks < 8; ++ks) {
                const bf16x8 bfr = {blo[ks][0], blo[ks][1], blo[ks][2], blo[ks][3], bhi[ks][0], bhi[ks][1], bhi[ks][2], bhi[ks][3]};
#pragma unroll
                for (int mb = 0; mb < 4; ++mb) { const bf16x8 af = *(const LAS bf16x8*)(tab + ((size_t)((mb * 16 + plane * 8 + ks) * 64 + F.lane)) * 16);
                    acc[mb] = __builtin_amdgcn_mfma_f32_32x32x16_bf16(af, bfr, acc[mb], 0, 0, 0); }
            }
            __builtin_amdgcn_sched_barrier(0);
        }
        const int n = n0 + l31;
#pragma unroll
        for (int mb = 0; mb < 4; ++mb)
#pragma unroll
            for (int r = 0; r < 16; ++r) { const int k2 = mb * 32 + crow32(r, hh); const size_t t = (size_t)b * SEQ + k1 + 64 * k2;
                ymix[t * DM + n] = f2bf(acc[mb][r]); }
    }
    __syncthreads();
}


__device__ __forceinline__ void qk_norm_rope_phase(const Ctx& F, bf16_t* __restrict__ proj, const float* __restrict__ qn, const float* __restrict__ kn, const float2* __restrict__ rope,
                                                   bf16_t* __restrict__ kc, bf16_t* __restrict__ vc) {
    const int a = F.lane >> 5, i = F.lane & 31, off = 64 * a + i;
    const float gq1 = qn[off], gq2 = qn[off + 32], gk1 = kn[off], gk2 = kn[off + 32];
    for (int t = F.bid * NWAVES + F.wave; t < NTOK; t += F.G * NWAVES) {
        const int s = t & (SEQ - 1), b = t / SEQ;
        bf16_t* p = proj + (size_t)t * ATT_IN + off;
        bf16_t r1[12], r2[12];
#pragma unroll
        for (int sl = 0; sl < 12; ++sl) { r1[sl] = p[sl * 128]; r2[sl] = p[sl * 128 + 32]; }
        const int pos = a ? (s & 63) : (s >> 6);
        const float2 cs = rope[pos * 32 + i];
#pragma unroll
        for (int sl = 0; sl < 10; ++sl) {
            float x1 = bf2f(r1[sl]), x2 = bf2f(r2[sl]);
            const float ss = wave_sum(x1 * x1 + x2 * x2) * (1.0f / 128.0f);
            const float r = rsqrtf(ss + LN_EPS);
            x1 = x1 * r * (sl < 8 ? gq1 : gk1); x2 = x2 * r * (sl < 8 ? gq2 : gk2);
            bf16_t* o = (sl < 8) ? p + sl * 128 : kc + ((size_t)(b * 2 + (sl - 8)) * SEQ + s) * 128 + off;
            o[0] = f2bf(x1 * cs.x - x2 * cs.y); o[32] = f2bf(x2 * cs.x + x1 * cs.y);
        }
#pragma unroll
        for (int sl = 10; sl < 12; ++sl) { bf16_t* o = vc + ((size_t)(b * 2 + (sl - 10)) * SEQ + s) * 128 + off; o[0] = r1[sl]; o[32] = r2[sl]; }
    }
}

__device__ __forceinline__ void natten_phase(const Ctx& F, const bf16_t* __restrict__ proj, const float* __restrict__ rpb, bf16_t* __restrict__ ymix) {
    LAS float* wl = (LAS float*)(F.lds + F.wave * 1024);
    LAS unsigned* ql = (LAS unsigned*)wl; LAS float* pl = wl + 64;
    for (int it = F.bid * NWAVES + F.wave; it < NTOK * 8; it += F.G * NWAVES) {
        const int hh = it & 7, t = it >> 3, s = t & (SEQ - 1), r = s >> 6, j = s & 63;
        const int rs = min(max(r - 4, 0), 120), cs = min(max(j - 8, 0), 48);
        const bf16_t* qp = proj + (size_t)t * ATT_IN + 1536 + hh * 128;
        const bf16_t* kbase = proj + (size_t)(t - s) * ATT_IN + 2560 + hh * 128;
        const bf16_t* vbase = proj + (size_t)(t - s) * ATT_IN + 3584 + hh * 128;
        ql[F.lane] = *(const unsigned*)(qp + 2 * F.lane);
        asm volatile("s_waitcnt lgkmcnt(0)" ::: "memory");
        float sc2[2];
#pragma unroll
        for (int kk2 = 0; kk2 < 2; ++kk2) {
            const int kk = F.lane + 64 * kk2, i = kk >> 4, w = kk & 15;
            const bf16_t* kr = kbase + (size_t)((rs + i) * 64 + cs + w) * ATT_IN;
            float acc = 0.f;
#pragma unroll
            for (int d8 = 0; d8 < 16; ++d8) { const u32x4 kv = *(const u32x4*)(kr + d8 * 8); const u32x4 qv = *(const LAS u32x4*)(ql + d8 * 4);
                acc = fmaf(bflo(kv.x), bflo(qv.x), acc); acc = fmaf(bfhi(kv.x), bfhi(qv.x), acc); acc = fmaf(bflo(kv.y), bflo(qv.y), acc); acc = fmaf(bfhi(kv.y), bfhi(qv.y), acc);
                acc = fmaf(bflo(kv.z), bflo(qv.z), acc); acc = fmaf(bfhi(kv.z), bfhi(qv.z), acc); acc = fmaf(bflo(kv.w), bflo(qv.w), acc); acc = fmaf(bfhi(kv.w), bfhi(qv.w), acc); }
            const int ro = rs + i - r + 7, co = cs + w - j + 15;
            sc2[kk2] = acc * ATT_SCALE + rpb[(hh * 15 + ro) * 31 + co];
        }
        const float mx = wave_max(fmaxf(sc2[0], sc2[1]));
        const float e0 = __expf(sc2[0] - mx), e1 = __expf(sc2[1] - mx);
        const float inv = 1.0f / wave_sum(e0 + e1);
        pl[F.lane] = e0 * inv; pl[F.lane + 64] = e1 * inv;
        asm volatile("s_waitcnt lgkmcnt(0)" ::: "memory");
        float o0 = 0.f, o1 = 0.f;
#pragma unroll 8
        for (int kk = 0; kk < 128; ++kk) { const int i = kk >> 4, w = kk & 15;
            const unsigned vv = *(const unsigned*)(vbase + (size_t)((rs + i) * 64 + cs + w) * ATT_IN + 2 * F.lane); const float pw = pl[kk];
            o0 = fmaf(pw, bflo(vv), o0); o1 = fmaf(pw, bfhi(vv), o1); }
        *(unsigned*)(ymix + (size_t)t * DM + 1024 + hh * 128 + 2 * F.lane) = cvt_pk_bf16(o0, o1);
    }
    __syncthreads();
}

__device__ __forceinline__ float xlane_f(float v, int srclane) { return __int_as_float(__builtin_amdgcn_ds_bpermute(srclane << 2, __float_as_int(v))); }
template <int OFF> __device__ __forceinline__ s16x4 tr_read_b64(int addr) {
    s16x4 r; asm volatile("ds_read_b64_tr_b16 %0, %1 offset:%2" : "=&v"(r) : "v"(addr), "i"(OFF) : "memory"); return r;
}
__device__ __forceinline__ void natten_pv_row(f32x4 (&o)[8], int trb, bf16x8 pb) {
    s16x4 lo[8], hi[8];
    lo[0] = tr_read_b64<0 * 32>(trb); hi[0] = tr_read_b64<0 * 32 + 16 * 288>(trb); lo[1] = tr_read_b64<1 * 32>(trb); hi[1] = tr_read_b64<1 * 32 + 16 * 288>(trb);
    lo[2] = tr_read_b64<2 * 32>(trb); hi[2] = tr_read_b64<2 * 32 + 16 * 288>(trb); lo[3] = tr_read_b64<3 * 32>(trb); hi[3] = tr_read_b64<3 * 32 + 16 * 288>(trb);
    lo[4] = tr_read_b64<4 * 32>(trb); hi[4] = tr_read_b64<4 * 32 + 16 * 288>(trb); lo[5] = tr_read_b64<5 * 32>(trb); hi[5] = tr_read_b64<5 * 32 + 16 * 288>(trb);
    lo[6] = tr_read_b64<6 * 32>(trb); hi[6] = tr_read_b64<6 * 32 + 16 * 288>(trb); lo[7] = tr_read_b64<7 * 32>(trb); hi[7] = tr_read_b64<7 * 32 + 16 * 288>(trb);
    asm volatile("s_waitcnt lgkmcnt(0)" ::: "memory"); __builtin_amdgcn_sched_barrier(0);
#pragma unroll
    for (int mt = 0; mt < 8; ++mt) { const bf16x8 a = {lo[mt][0], lo[mt][1], lo[mt][2], lo[mt][3], hi[mt][0], hi[mt][1], hi[mt][2], hi[mt][3]};
        o[mt] = __builtin_amdgcn_mfma_f32_16x16x32_bf16(a, pb, o[mt], 0, 0, 0); }
    __builtin_amdgcn_sched_barrier(0);
}
__device__ __forceinline__ void natten_mfma_phase(const Ctx& F, const bf16_t* __restrict__ proj, const float* __restrict__ rpb, bf16_t* __restrict__ ymix) {
    LAS float* bl = (LAS float*)(F.lds + 8 * 9216);
    for (int i = F.tid; i < 8 * 15 * 31; i += NTHREADS) bl[i] = rpb[i];
    __syncthreads();
    LAS unsigned char* vt = F.lds + F.wave * 9216;
    const int n16 = F.lane & 15, g = F.lane >> 4;
    const int trb = (int)(uintptr_t)vt + (4 * g + (n16 >> 2)) * 288 + (n16 & 3) * 8;
    for (int it = F.bid * NWAVES + F.wave; it < 2 * 8 * 128 * 4; it += F.G * NWAVES) {
        const int qb = it & 3, r = (it >> 2) & 127, hh = (it >> 9) & 7, b = it >> 12;
        const int rs = min(max(r - 4, 0), 120), j0 = qb * 16, c0 = min(max(j0 - 8, 0), 32);
        const size_t tb = (size_t)b * SEQ;
        const int j = j0 + n16, cs = min(max(j - 8, 0), 48);
        const bf16_t* qrow = proj + (tb + r * 64 + j) * ATT_IN + 1536 + hh * 128 + 8 * g;
        bf16x8 qf[4];
#pragma unroll
        for (int ks = 0; ks < 4; ++ks) qf[ks] = *(const bf16x8*)(qrow + 32 * ks);
        float sc[8][2][4];
        float mx = -1e30f;
#pragma unroll
        for (int i = 0; i < 8; ++i)
#pragma unroll
            for (int kt = 0; kt < 2; ++kt) {
                const bf16_t* krow = proj + (tb + (rs + i) * 64 + c0 + 16 * kt + n16) * ATT_IN + 2560 + hh * 128 + 8 * g;
                f32x4 a = {0.f, 0.f, 0.f, 0.f};
#pragma unroll
                for (int ks = 0; ks < 4; ++ks) a = __builtin_amdgcn_mfma_f32_16x16x32_bf16(*(const bf16x8*)(krow + 32 * ks), qf[ks], a, 0, 0, 0);
                const LAS float* brow = bl + (hh * 15 + (rs + i - r + 7)) * 31;
#pragma unroll
                for (int q = 0; q < 4; ++q) { const int kc = c0 + 16 * kt + 4 * g + q; const bool ok = (kc >= cs) && (kc < cs + 16);
                    const float bias = brow[ok ? (kc - j + 15) : 0];
                    const float s = ok ? fmaf(a[q], ATT_SCALE, bias) : -1e30f;
                    sc[i][kt][q] = s; mx = fmaxf(mx, s); }
            }
        mx = fmaxf(mx, xlane_f(mx, F.lane ^ 16)); mx = fmaxf(mx, xlane_f(mx, F.lane ^ 32));
        float sum = 0.f;
#pragma unroll
        for (int i = 0; i < 8; ++i)
#pragma unroll
            for (int kt = 0; kt < 2; ++kt)
#pragma unroll
                for (int q = 0; q < 4; ++q) { const float e = __expf(sc[i][kt][q] - mx); sc[i][kt][q] = e; sum += e; }
        sum += xlane_f(sum, F.lane ^ 16); sum += xlane_f(sum, F.lane ^ 32);
        const float inv = 1.0f / sum;
        f32x4 o[8];
#pragma unroll
        for (int mt = 0; mt < 8; ++mt) o[mt] = (f32x4){0.f, 0.f, 0.f, 0.f};
#pragma unroll
        for (int i = 0; i < 8; ++i) {
            u32x4 vv[8];
#pragma unroll
            for (int c = 0; c < 8; ++c) { const int id = F.lane + 64 * c, row = id >> 4, col16 = id & 15;
                vv[c] = *(const u32x4*)(proj + (tb + (rs + i) * 64 + c0 + row) * ATT_IN + 3584 + hh * 128 + col16 * 8); }
            asm volatile("s_waitcnt lgkmcnt(0)" ::: "memory");
#pragma unroll
            for (int c = 0; c < 8; ++c) { const int id = F.lane + 64 * c, row = id >> 4, col16 = id & 15;
                *(LAS u32x4*)(vt + row * 288 + col16 * 16) = vv[c]; }
            asm volatile("s_waitcnt lgkmcnt(0)" ::: "memory");
            u32x4 w; w.x = cvt_pk_bf16(sc[i][0][0], sc[i][0][1]); w.y = cvt_pk_bf16(sc[i][0][2], sc[i][0][3]); w.z = cvt_pk_bf16(sc[i][1][0], sc[i][1][1]); w.w = cvt_pk_bf16(sc[i][1][2], sc[i][1][3]);
            const bf16x8 pb = *reinterpret_cast<bf16x8*>(&w);
            natten_pv_row(o, trb, pb);
        }
        bf16_t* orow = ymix + (tb + r * 64 + j) * DM + 1024 + hh * 128 + 4 * g;
#pragma unroll
        for (int mt = 0; mt < 8; ++mt) { u32x2 w; w.x = cvt_pk_bf16(o[mt][0] * inv, o[mt][1] * inv); w.y = cvt_pk_bf16(o[mt][2] * inv, o[mt][3] * inv);
            *(u32x2*)(orow + 16 * mt) = w; }
    }
    __syncthreads();
}

__device__ __forceinline__ unsigned sortable(float f) { const unsigned u = __float_as_uint(f); return (u & 0x80000000u) ? ~u : (u | 0x80000000u); }
__device__ __forceinline__ float unsortable(unsigned k) { return __uint_as_float((k & 0x80000000u) ? (k ^ 0x80000000u) : ~k); }
#define INS16(L, key) do { unsigned _k = (key); _Pragma("unroll") for (int _m = 0; _m < 16; ++_m) { const unsigned _h = max(L[_m], _k); _k = min(L[_m], _k); L[_m] = _h; } } while (0)
__device__ __forceinline__ void sort16_desc(unsigned (&a)[16]) {
#pragma unroll
    for (int k = 2; k <= 16; k <<= 1)
#pragma unroll
        for (int j = k >> 1; j >= 1; j >>= 1)
#pragma unroll
            for (int i = 0; i < 16; ++i) { const int l = i ^ j; if (l > i) { const unsigned hi = max(a[i], a[l]), lo = min(a[i], a[l]); if ((i & k) == 0) { a[i] = hi; a[l] = lo; } else { a[i] = lo; a[l] = hi; } } }
}
__device__ __forceinline__ void merge_top16(unsigned (&R)[16], const unsigned (&C)[16]) {
#pragma unroll
    for (int i = 0; i < 16; ++i) R[i] = max(R[i], C[15 - i]);
#pragma unroll
    for (int j = 8; j >= 1; j >>= 1)
#pragma unroll
        for (int i = 0; i < 16; ++i) { const int l = i ^ j; if (l > i) { const unsigned hi = max(R[i], R[l]), lo = min(R[i], R[l]); R[i] = hi; R[l] = lo; } }
}
__device__ __forceinline__ void topk_phase(const Ctx& F, const bf16_t* __restrict__ sc, int* __restrict__ eidx, float* __restrict__ eg) {
    constexpr int RS = 80;
    for (int blk = F.bid; blk < NTOK / 64; blk += F.G) {
        const bf16_t* slab = sc + (size_t)blk * 64 * DM;
        unsigned L1[16], L2[16], Fk[16];
#pragma unroll
        for (int m = 0; m < 16; ++m) { L1[m] = 0u; L2[m] = 0u; Fk[m] = 0u; }
        u32x4 pre[4];
#pragma unroll
        for (int q = 0; q < 4; ++q) { const int idx = q * NTHREADS + F.tid; pre[q] = *(const u32x4*)(slab + (size_t)(idx >> 2) * 256 + (idx & 3) * 8); }
#pragma unroll 1
        for (int c = 0; c < 8; ++c) {
            __syncthreads();
#pragma unroll
            for (int q = 0; q < 4; ++q) { const int idx = q * NTHREADS + F.tid; *(LAS u32x4*)(F.lds + (idx >> 2) * RS + (idx & 3) * 16) = pre[q]; }
            if (c + 1 < 8) {
#pragma unroll
                for (int q = 0; q < 4; ++q) { const int idx = q * NTHREADS + F.tid; pre[q] = *(const u32x4*)(slab + (size_t)(idx >> 2) * 256 + (c + 1) * 32 + (idx & 3) * 8); } }
            __syncthreads();
            const unsigned nb = (unsigned)((c & 3) * 32);
#pragma unroll
            for (int h = 0; h < 2; ++h) {
                unsigned C[16];
#pragma unroll
                for (int s2 = 0; s2 < 2; ++s2) { const u32x4 w = *(const LAS u32x4*)(F.lds + F.tid * RS + (h * 2 + s2) * 16);
                    const float a[8] = {bflo(w.x), bfhi(w.x), bflo(w.y), bfhi(w.y), bflo(w.z), bfhi(w.z), bflo(w.w), bfhi(w.w)};
#pragma unroll
                    for (int i = 0; i < 8; ++i) C[s2 * 8 + i] = (sortable(a[i]) & ~0x7Fu) | (127u - (nb + (unsigned)(h * 16 + s2 * 8 + i))); }
                sort16_desc(C);
                if (c < 4) merge_top16(L1, C); else merge_top16(L2, C);
            }
        }
        float v1[16], v2[16]; unsigned x1[16], x2[16];
#pragma unroll
        for (int m = 0; m < 16; ++m) { v1[m] = unsortable(L1[m] & ~0x7Fu); v2[m] = unsortable(L2[m] & ~0x7Fu); x1[m] = (127u - (L1[m] & 0x7Fu)) << 7; x2[m] = 127u - (L2[m] & 0x7Fu); }
#pragma unroll
        for (int i = 0; i < 16; ++i)
#pragma unroll
            for (int j = 0; j < 16; ++j) if ((i + 1) * (j + 1) <= 16) { const unsigned key = (sortable(v1[i] + v2[j]) & ~0x3FFFu) | x1[i] | x2[j]; INS16(Fk, key); }
        float g[16]; const float mx = unsortable(Fk[0] & ~0x3FFFu); float sum = 0.f;
#pragma unroll
        for (int m = 0; m < 16; ++m) { g[m] = __expf(unsortable(Fk[m] & ~0x3FFFu) - mx); sum += g[m]; }
        const float inv = 1.0f / sum;
        const size_t pair = (size_t)blk * 512 + F.tid;
        int* eo = eidx + pair * 16; float* go = eg + pair * 16;
#pragma unroll
        for (int m = 0; m < 16; ++m) { eo[m] = (int)(Fk[m] & 0x3FFFu); go[m] = g[m] * inv; }
    }
    __syncthreads();
}


__device__ __forceinline__ int wave_sum_i(int v) {
#define DPPI(v, ctrl) __builtin_amdgcn_update_dpp(0, (v), (ctrl), 0xF, 0xF, true)
    v += DPPI(v, 0xB1); v += DPPI(v, 0x4E); v += DPPI(v, 0x141); v += DPPI(v, 0x140);
#undef DPPI
    return (__builtin_amdgcn_readlane(v, 0) + __builtin_amdgcn_readlane(v, 16)) + (__builtin_amdgcn_readlane(v, 32) + __builtin_amdgcn_readlane(v, 48));
}
__device__ __forceinline__ void l16_load_f32(const float* __restrict__ row, int lane, float (&v)[32]) {
#pragma unroll
    for (int c = 0; c < 2; ++c)
#pragma unroll
        for (int q = 0; q < 4; ++q) { const f32x4 a = *(const f32x4*)(row + c * 1024 + lane * 16 + q * 4);
#pragma unroll
            for (int i = 0; i < 4; ++i) v[c * 16 + q * 4 + i] = a[i]; }
}
__device__ __forceinline__ void l16_store_f32(float* __restrict__ row, int lane, const float (&v)[32]) {
#pragma unroll
    for (int c = 0; c < 2; ++c)
#pragma unroll
        for (int q = 0; q < 4; ++q) { f32x4 a;
#pragma unroll
            for (int i = 0; i < 4; ++i) a[i] = v[c * 16 + q * 4 + i];
            *(f32x4*)(row + c * 1024 + lane * 16 + q * 4) = a; }
}
__device__ __forceinline__ void l16_store_bf16(bf16_t* __restrict__ row, int lane, const float (&v)[32]) {
#pragma unroll
    for (int c = 0; c < 2; ++c)
#pragma unroll
        for (int q = 0; q < 2; ++q) { u32x4 w;
            w.x = cvt_pk_bf16(v[c * 16 + q * 8 + 0], v[c * 16 + q * 8 + 1]); w.y = cvt_pk_bf16(v[c * 16 + q * 8 + 2], v[c * 16 + q * 8 + 3]);
            w.z = cvt_pk_bf16(v[c * 16 + q * 8 + 4], v[c * 16 + q * 8 + 5]); w.w = cvt_pk_bf16(v[c * 16 + q * 8 + 6], v[c * 16 + q * 8 + 7]);
            *(u32x4*)(row + c * 1024 + lane * 16 + q * 8) = w; }
}
__device__ __forceinline__ float ub0(unsigned x) { float f; asm("v_cvt_f32_ubyte0 %0, %1" : "=v"(f) : "v"(x)); return f; }
__device__ __forceinline__ float ub1(unsigned x) { float f; asm("v_cvt_f32_ubyte1 %0, %1" : "=v"(f) : "v"(x)); return f; }
__device__ __forceinline__ float ub2(unsigned x) { float f; asm("v_cvt_f32_ubyte2 %0, %1" : "=v"(f) : "v"(x)); return f; }
__device__ __forceinline__ float ub3(unsigned x) { float f; asm("v_cvt_f32_ubyte3 %0, %1" : "=v"(f) : "v"(x)); return f; }
#define UB0(x) ub0(x)
#define UB1(x) ub1(x)
#define UB2(x) ub2(x)
#define UB3(x) ub3(x)
__device__ __forceinline__ float reduce_scatter8(const float (&p)[8], int lane) {
    const bool b0 = (lane & 1) != 0, b1 = (lane & 2) != 0, b2 = (lane & 4) != 0;
    float r1[4], r2[2];
#pragma unroll
    for (int j = 0; j < 4; ++j) { const float a = b0 ? p[2 * j + 1] : p[2 * j], b = b0 ? p[2 * j] : p[2 * j + 1]; r1[j] = a + DPPF(b, 0xB1); }
#pragma unroll
    for (int j = 0; j < 2; ++j) { const float a = b1 ? r1[2 * j + 1] : r1[2 * j], b = b1 ? r1[2 * j] : r1[2 * j + 1]; r2[j] = a + DPPF(b, 0x4E); }
    float r3;
    { const float a = b2 ? r2[1] : r2[0], b = b2 ? r2[0] : r2[1]; const float t = DPPF(b, 0x141); r3 = a + DPPF(t, 0x1B); }
    { const float t = DPPF(r3, 0x140); r3 += DPPF(t, 0x141); }
    { auto s = __builtin_amdgcn_permlane16_swap(__float_as_uint(r3), __float_as_uint(r3), false, false); r3 = __uint_as_float(s[0]) + __uint_as_float(s[1]); }
    { auto s = __builtin_amdgcn_permlane32_swap(__float_as_uint(r3), __float_as_uint(r3), false, false); r3 = __uint_as_float(s[0]) + __uint_as_float(s[1]); }
    return r3;
}
#define PIN16(a, o) asm volatile("" : "+v"(a[(o)+0]), "+v"(a[(o)+1]), "+v"(a[(o)+2]), "+v"(a[(o)+3]), "+v"(a[(o)+4]), "+v"(a[(o)+5]), "+v"(a[(o)+6]), "+v"(a[(o)+7]), \
    "+v"(a[(o)+8]), "+v"(a[(o)+9]), "+v"(a[(o)+10]), "+v"(a[(o)+11]), "+v"(a[(o)+12]), "+v"(a[(o)+13]), "+v"(a[(o)+14]), "+v"(a[(o)+15]))
template <int J> __device__ __forceinline__ unsigned lane_xor(unsigned v, const int lane) {
    if constexpr (J == 1) return (unsigned)__builtin_amdgcn_update_dpp(0, (int)v, 0xB1, 0xF, 0xF, true);
    else if constexpr (J == 2) return (unsigned)__builtin_amdgcn_update_dpp(0, (int)v, 0x4E, 0xF, 0xF, true);
    else if constexpr (J == 4) { const int t = __builtin_amdgcn_update_dpp(0, (int)v, 0x141, 0xF, 0xF, true); return (unsigned)__builtin_amdgcn_update_dpp(0, t, 0x1B, 0xF, 0xF, true); }
    else if constexpr (J == 8) { const int t = __builtin_amdgcn_update_dpp(0, (int)v, 0x140, 0xF, 0xF, true); return (unsigned)__builtin_amdgcn_update_dpp(0, t, 0x141, 0xF, 0xF, true); }
    else if constexpr (J == 16) { auto s = __builtin_amdgcn_permlane16_swap(v, v, false, false); return (lane & 16) ? s[0] : s[1]; }
    else { auto s = __builtin_amdgcn_permlane32_swap(v, v, false, false); return (lane & 32) ? s[0] : s[1]; }
}
template <int K, int J> __device__ __forceinline__ void sort128_stage(unsigned& k0, unsigned& k1, const int lane) {
    if constexpr (J == 64) { const unsigned lo = min(k0, k1), hi = max(k0, k1); k0 = lo; k1 = hi; }
    else {
        const unsigned p0 = lane_xor<J>(k0, lane), p1 = lane_xor<J>(k1, lane);
        const bool lower = (lane & J) == 0;
        const bool asc0 = (K == 128) ? true : ((lane & K) == 0), asc1 = (K == 128) ? true : (((64 + lane) & K) == 0);
        k0 = (lower == asc0) ? min(k0, p0) : max(k0, p0);
        k1 = (lower == asc1) ? min(k1, p1) : max(k1, p1);
    }
}
template <int K, int J> __device__ __forceinline__ void sort128_k(unsigned& k0, unsigned& k1, const int lane) {
    sort128_stage<K, J>(k0, k1, lane);
    if constexpr (J > 1) sort128_k<K, J / 2>(k0, k1, lane);
}
__device__ __forceinline__ void wave_sort128(unsigned& k0, unsigned& k1, const int lane) {
    sort128_k<2, 1>(k0, k1, lane); sort128_k<4, 2>(k0, k1, lane); sort128_k<8, 4>(k0, k1, lane); sort128_k<16, 8>(k0, k1, lane);
    sort128_k<32, 16>(k0, k1, lane); sort128_k<64, 32>(k0, k1, lane); sort128_k<128, 64>(k0, k1, lane);
}
#define DPPI_(v, ctrl) __builtin_amdgcn_update_dpp(0, (v), (ctrl), 0xF, 0xF, true)
template <int N> __device__ __forceinline__ float bcast8(float c) {
    const int t1 = __builtin_amdgcn_update_dpp(0, __float_as_int(c), 0x150 + N, 0xF, 0x3, false);
    return __int_as_float(__builtin_amdgcn_update_dpp(t1, __float_as_int(c), 0x158 + N, 0xF, 0xC, false));
}
__device__ __forceinline__ void peer_scales_to_lds(const Ctx& F, const bf16_t* __restrict__ s  ) {
    const u32x4* sp = (const u32x4*)s;
    for (int i = F.tid; i < NEXP * 8 / 16; i += NTHREADS) *(LAS u32x4*)(F.lds + i * 16) = sp[i];
    __syncthreads();
}
#define PEER_IDS(I, tt) do { const int* ip_ = eidx + (size_t)(tt) * 128 + g * 16; _Pragma("unroll") for (int c_ = 0; c_ < 4; ++c_) I[c_] = *(const u32x4*)(ip_ + c_ * 4); } while (0)
#define PEER_ID(I, k) (I[(k) >> 2][(k) & 3])
#define PEER_LD8(D, rs, I, b) do { _Pragma("unroll") for (int k_ = 0; k_ < 8; ++k_) D[k_] = __builtin_amdgcn_raw_buffer_load_b128(rs, (int)((PEER_ID(I, (b) * 8 + k_) << 7) + p16), 0, 0); } while (0)
#define PEER_SC8(S, I, b) do { _Pragma("unroll") for (int k_ = 0; k_ < 8; ++k_) S[k_] = (unsigned)*(const LAS unsigned short*)(F.lds + (PEER_ID(I, (b) * 8 + k_) << 3) + ph2); } while (0)
#define PEER_ZERO4(A, n) do { _Pragma("unroll") for (int z_ = 0; z_ < (n); ++z_) A[z_] = (u32x4){0u, 0u, 0u, 0u}; } while (0)
#define PEER_COPY4(A, B, n) do { _Pragma("unroll") for (int z_ = 0; z_ < (n); ++z_) A[z_] = B[z_]; } while (0)

__device__ __forceinline__ void peer_dots_phase(const Ctx& F, const unsigned char* __restrict__ h8, const int* __restrict__ eidx,
                                                const unsigned char* __restrict__ u4, const bf16_t* __restrict__ su, float* __restrict__ part) {
    const int x = F.bid & 7, q = F.bid >> 3, nq = (F.G - x + 7) >> 3, tstep = nq * NWAVES;
    peer_scales_to_lds(F, su + (size_t)x * NEXP * 4);
    const __amdgpu_buffer_rsrc_t r_u = __builtin_amdgcn_make_buffer_rsrc((void*)(u4 + (size_t)x * NEXP * 128), 0, NEXP * 128, 0x00020000);
#define PEER_HQ(H, tt) do { const unsigned char* hp_ = h8 + (size_t)(tt) * DM + (unsigned)((x * 8 + p) * 16); H[0] = *(const u32x4*)hp_; H[1] = *(const u32x4*)(hp_ + 1024); } while (0)
#define PEER_DOT8(D, S, H, keep) do { _Pragma("unroll") for (int k_ = 0; k_ < 8; ++k_) { int sh_ = 0, sl_ = 0; \
        sh_ = __builtin_amdgcn_sdot8((int)H[0].x, (int)D[k_].x, sh_, false); sl_ = __builtin_amdgcn_sdot8((int)H[1].x, (int)D[k_].x, sl_, false); \
        sh_ = __builtin_amdgcn_sdot8((int)H[0].y, (int)D[k_].y, sh_, false); sl_ = __builtin_amdgcn_sdot8((int)H[1].y, (int)D[k_].y, sl_, false); \
        sh_ = __builtin_amdgcn_sdot8((int)H[0].z, (int)D[k_].z, sh_, false); sl_ = __builtin_amdgcn_sdot8((int)H[1].z, (int)D[k_].z, sl_, false); \
        sh_ = __builtin_amdgcn_sdot8((int)H[0].w, (int)D[k_].w, sh_, false); sl_ = __builtin_amdgcn_sdot8((int)H[1].w, (int)D[k_].w, sl_, false); \
        int s_ = sh_ * 16 + sl_; s_ += DPPI_(s_, 0xB1);                       \
        float v_ = (float)s_ * __uint_as_float(S[k_] << 16); v_ += DPPF(v_, 0x4E); v_ += DPPF(v_, 0x141);     \
        keep = (p == k_) ? v_ : keep; } } while (0)
    int t = q * NWAVES + F.wave;
    u32x4 I0[4], I1[4], I2[4], H0[2], H1[2], Da[8], Db[8];
    PEER_ZERO4(I0, 4); PEER_ZERO4(I1, 4); PEER_ZERO4(I2, 4); PEER_ZERO4(H0, 2); PEER_ZERO4(H1, 2); PEER_ZERO4(Da, 8); PEER_ZERO4(Db, 8);
    { const int p = F.lane & 7, g = F.lane >> 3; const unsigned p16 = (unsigned)p * 16u;
      if (t < NTOK) { PEER_IDS(I0, t); PEER_HQ(H0, t); }
      if (t + tstep < NTOK) PEER_IDS(I1, t + tstep);
      if (t < NTOK) PEER_LD8(Da, r_u, I0, 0); }
#pragma unroll 1
    for (; t < NTOK; t += tstep) {
        int lane = F.lane; asm volatile("" : "+v"(lane));
        const int p = lane & 7, g = lane >> 3; const unsigned p16 = (unsigned)p * 16u, ph2 = (unsigned)(p >> 1) * 2u;
        const int tn = t + tstep, tnn = t + 2 * tstep;
        PEER_LD8(Db, r_u, I0, 1);
        __builtin_amdgcn_sched_barrier(0);
        if (tnn < NTOK) PEER_IDS(I2, tnn);
        if (tn < NTOK) PEER_HQ(H1, tn);
        unsigned Sa[8], Sb[8]; PEER_SC8(Sa, I0, 0); PEER_SC8(Sb, I0, 1);
        float keep0 = 0.f, keep1 = 0.f;
        __builtin_amdgcn_sched_barrier(0);
        PEER_DOT8(Da, Sa, H0, keep0);
        __builtin_amdgcn_sched_barrier(0);
        if (tn < NTOK) PEER_LD8(Da, r_u, I1, 0);
        __builtin_amdgcn_sched_barrier(0);
        PEER_DOT8(Db, Sb, H0, keep1);
        float* po = part + ((size_t)t * 8 + x) * 128 + g * 16 + p; po[0] = keep0; po[8] = keep1;
        PEER_COPY4(I0, I1, 4); PEER_COPY4(I1, I2, 4); PEER_COPY4(H0, H1, 2);
    }
    __syncthreads();
#undef PEER_HQ
#undef PEER_DOT8
}

__device__ __forceinline__ void peer_coef_phase(const Ctx& F, const float* __restrict__ part, const float* __restrict__ hs, const float* __restrict__ eg, const int* __restrict__ eidx,
                                                const bf16_t* __restrict__ sv  , unsigned short* __restrict__ ids, unsigned char* __restrict__ W8, unsigned* __restrict__ SC) {
    for (int idx = F.bid * NTHREADS + F.tid; idx < NTOK * 128; idx += F.G * NTHREADS) {
        const int t = idx >> 7, j = idx & 127;
        const float* pp = part + (size_t)t * 1024 + j;
        float s = 0.f;
#pragma unroll
        for (int x = 0; x < 8; ++x) s += pp[x * 128];
        const int e = eidx[idx];
        const float c = eg[idx] * gelu_erf(s * hs[t]);
        const u32x4 sc = *(const u32x4*)(sv + (size_t)e * 8);
        ids[idx] = (unsigned short)e;
        const int ee = j & 15, st = j >> 4, gB = (ee < 8) ? (ee >> 1) : ((ee - 8) >> 1), qq = (ee < 8) ? (ee & 1) : (2 + (ee & 1));
        unsigned char* wp = W8 + (size_t)t * 1024 + gB * 32 + st * 4 + qq;
        unsigned* sp = SC + (size_t)t * 64 + st;
        const float rs[8] = {bflo(sc.x), bfhi(sc.x), bflo(sc.y), bfhi(sc.y), bflo(sc.z), bfhi(sc.z), bflo(sc.w), bfhi(sc.w)};
#pragma unroll
        for (int x = 0; x < 8; ++x) {
            const float w = c * rs[x];
            float m = fabsf(w);
            m = fmaxf(m, DPPF(m, 0xB1)); m = fmaxf(m, DPPF(m, 0x4E)); m = fmaxf(m, DPPF(m, 0x141)); m = fmaxf(m, DPPF(m, 0x140));
            const int bexp = max((int)(__float_as_uint(m) >> 23), 16);
            const float fac = __uint_as_float((unsigned)(261 - bexp) << 23);
            wp[x * 128] = (unsigned char)(__builtin_amdgcn_cvt_pk_fp8_f32(w * fac, 0.f, 0, false) & 0xFF);
            if (ee == 0) { const unsigned sb1 = (unsigned)(bexp - 7); sp[x * 8] = sb1 * 0x01010101u; }
        }
    }
}

typedef int i32x8 __attribute__((ext_vector_type(8)));
#define PEER_CONST_SCALE 0
#define PEER_SELFTEST 0
__device__ __forceinline__ void peer_acc_phase(const Ctx& F, const unsigned short* __restrict__ ids, const unsigned char* __restrict__ W8, const unsigned* __restrict__ SC, const unsigned char* __restrict__ v4,
                                               const bf16_t* __restrict__ uin  , const float* __restrict__ lns  ,
                                               const float* __restrict__ g0, const float* __restrict__ b0, const float* __restrict__ gate  , bf16_t* __restrict__ y2) {
    const int x = F.bid & 7, q = F.bid >> 3, nq = (F.G - x + 7) >> 3, tstep = nq * NWAVES;
    { LAS float* lv = (LAS float*)F.lds;
      if (F.tid < 256) { lv[F.tid] = g0[x * 256 + F.tid]; lv[256 + F.tid] = b0[x * 256 + F.tid]; lv[512 + F.tid] = gate[x * 256 + F.tid]; lv[768 + F.tid] = gate[6144 + x * 256 + F.tid]; } }
    __syncthreads();
    const __amdgpu_buffer_rsrc_t r_v = __builtin_amdgcn_make_buffer_rsrc((void*)(v4 + (size_t)x * NEXP * 128), 0, NEXP * 128, 0x00020000);
    const __amdgpu_buffer_rsrc_t r_y = __builtin_amdgcn_make_buffer_rsrc((void*)y2, 0, NTOK * DM * 2, 0x00020000);
    unsigned sel[8];
    { const int n0 = F.lane & 15;
#pragma unroll
      for (int i = 0; i < 4; ++i)
#pragma unroll
          for (int h = 0; h < 2; ++h) sel[2 * i + h] = (n0 < 8 && (n0 >> 2) == h) ? ((0x0C0C0C0Cu & ~(0xFFu << (8 * (n0 & 3)))) | ((unsigned)i << (8 * (n0 & 3)))) : 0x0C0C0C0Cu; }
#define PB_IDS(I, tt) do { const unsigned short* rp_ = ids + (size_t)(tt) * 128 + 8 * g8; I[0] = *(const u32x4*)rp_; I[1] = *(const u32x4*)(rp_ + 64); } while (0)
#define PB_CFS(C, tt) do { const unsigned char* rp_ = W8 + ((size_t)(tt) * 8 + x) * 128 + 32 * kg; const unsigned* sp_ = SC + ((size_t)(tt) * 8 + x) * 8; \
        C[0] = *(const u32x4*)rp_; C[1] = *(const u32x4*)(rp_ + 16); C[2] = *(const u32x4*)sp_; C[3] = *(const u32x4*)(sp_ + 4); } while (0)
#define PB_ID(I, h, k) (((k) & 1) ? (I[h][(k) >> 1] >> 16) : (I[h][(k) >> 1] & 0xFFFFu))
#define PB_LD8(D, I, h) do { _Pragma("unroll") for (int k_ = 0; k_ < 8; ++k_) D[k_] = __builtin_amdgcn_raw_buffer_load_b128(r_v, (int)((PB_ID(I, h, k_) << 7) + p16), 0, 0); } while (0)
#define PB_WR8(D) do { _Pragma("unroll") for (int k_ = 0; k_ < 8; ++k_) *(LAS u32x4*)(wl + k_ * 1024 + lane16) = D[k_]; } while (0)
#define PB_STEP(s) do { \
            unsigned a0_[4], a1_[4]; _Pragma("unroll") for (int i_ = 0; i_ < 4; ++i_) { const LAS unsigned* ap_ = (const LAS unsigned*)(wl + (4 * (kg & 1) + i_) * 1024 + (2 * ((s) & 3) + (kg >> 1)) * 128 + idx8); a0_[i_] = ap_[0]; a1_[i_] = ap_[1]; } \
            const unsigned W8_ = C0[(s) >> 2][(s) & 3]; const int scale_b = (int)C0[2 + ((s) >> 2)][(s) & 3];        \
            i32x8 Bm; _Pragma("unroll") for (int j = 0; j < 8; ++j) Bm[j] = (int)__builtin_amdgcn_perm(W8_, W8_, sel[j]); \
            const i32x8 A0 = {(int)a0_[0], (int)a0_[1], (int)a0_[2], (int)a0_[3], 0, 0, 0, 0}; \
            const i32x8 A1 = {(int)a1_[0], (int)a1_[1], (int)a1_[2], (int)a1_[3], 0, 0, 0, 0}; \
            acc0 = __builtin_amdgcn_mfma_scale_f32_16x16x128_f8f6f4(A0, Bm, acc0, 4, 0, 0, 0x7F7F7F7F, 0, scale_b); \
            acc1 = __builtin_amdgcn_mfma_scale_f32_16x16x128_f8f6f4(A1, Bm, acc1, 4, 0, 0, 0x7F7F7F7F, 0, scale_b); } while (0)
    int t = q * NWAVES + F.wave;
    u32x4 I0[2], I1[2], I2[2], Da[8], Db[8], C0[4], C1[4];
#pragma unroll
    for (int i = 0; i < 2; ++i) { I0[i] = (u32x4){0u, 0u, 0u, 0u}; I1[i] = I0[i]; I2[i] = I0[i]; }
#pragma unroll
    for (int i = 0; i < 8; ++i) { Da[i] = (u32x4){0u, 0u, 0u, 0u}; Db[i] = Da[i]; }
#pragma unroll
    for (int i = 0; i < 4; ++i) { C0[i] = (u32x4){0u, 0u, 0u, 0u}; C1[i] = C0[i]; }
    { const int kg = F.lane >> 4, g8 = F.lane >> 3; const unsigned p16 = (unsigned)(F.lane & 7) * 16u;
      if (t < NTOK) { PB_IDS(I0, t); PB_CFS(C0, t); }
      if (t + tstep < NTOK) PB_IDS(I1, t + tstep);
      if (t < NTOK) PB_LD8(Da, I0, 0); }
#pragma unroll 1
    for (; t < NTOK; t += tstep) {
        int lane = F.lane; asm volatile("" : "+v"(lane));
        const int idx = lane & 15, kg = lane >> 4, g8 = lane >> 3; const unsigned idx8 = (unsigned)idx * 8u, p16 = (unsigned)(lane & 7) * 16u, lane16 = (unsigned)lane * 16u;
        LAS unsigned char* wl = F.lds + 4096 + F.wave * 8192;
        const int tn = t + tstep, tnn = t + 2 * tstep;
        const unsigned colb = (unsigned)(x * 256 + kg * 64 + idx * 8);
        f32x4 acc0 = {0.f, 0.f, 0.f, 0.f}, acc1 = {0.f, 0.f, 0.f, 0.f};
        PB_LD8(Db, I0, 1);
        __builtin_amdgcn_sched_barrier(0);
        if (tnn < NTOK) PB_IDS(I2, tnn);
        if (tn < NTOK) PB_CFS(C1, tn);
        const u32x4 xw = *(const u32x4*)(uin + (size_t)t * DM + (idx < 8 ? colb : 0u));
        const float mu = lns[2 * t], rstd = lns[2 * t + 1];
        __builtin_amdgcn_sched_barrier(0);
        PB_WR8(Da);
        PB_STEP(0); PB_STEP(1); PB_STEP(2); PB_STEP(3);
        __builtin_amdgcn_sched_barrier(0);
        if (tn < NTOK) PB_LD8(Da, I1, 0);
        __builtin_amdgcn_sched_barrier(0);
        PB_WR8(Db);
        PB_STEP(4); PB_STEP(5); PB_STEP(6); PB_STEP(7);
        __builtin_amdgcn_sched_barrier(0);
        {
            const LAS float* lv = (const LAS float*)F.lds + kg * 64 + idx * 8;
            const LAS float* gp = lv + 512 + (t / SEQ) * 256;
            const f32x4 ga = *(const LAS f32x4*)lv, gb = *(const LAS f32x4*)(lv + 4), ba = *(const LAS f32x4*)(lv + 256), bb = *(const LAS f32x4*)(lv + 260), ta = *(const LAS f32x4*)gp, tb = *(const LAS f32x4*)(gp + 4);
            const float xr[8] = {bflo(xw.x), bfhi(xw.x), bflo(xw.y), bfhi(xw.y), bflo(xw.z), bfhi(xw.z), bflo(xw.w), bfhi(xw.w)};
            float val[8];
#pragma unroll
            for (int r = 0; r < 4; ++r) { const float xa_ = fmaf((xr[r] - mu) * rstd, ga[r], ba[r]), xb_ = fmaf((xr[4 + r] - mu) * rstd, gb[r], bb[r]);
#if PEER_CONST_SCALE
                val[r] = fmaf(ta[r] * (1.0f / 1024.0f), acc0[r], xa_ * ALPHA); val[4 + r] = fmaf(tb[r] * (1.0f / 1024.0f), acc1[r], xb_ * ALPHA); }
#else
                val[r] = fmaf(ta[r], acc0[r], xa_ * ALPHA); val[4 + r] = fmaf(tb[r], acc1[r], xb_ * ALPHA); }
#endif
            __builtin_amdgcn_raw_buffer_store_b128((u32x4){cvt_pk_bf16(val[0], val[1]), cvt_pk_bf16(val[2], val[3]), cvt_pk_bf16(val[4], val[5]), cvt_pk_bf16(val[6], val[7])}, r_y,
                                                   (int)(idx < 8 ? ((unsigned)t * (unsigned)DM + colb) * 2u : 0xFFFFFFF0u), 0, 0);
        }
        I0[0] = I1[0]; I0[1] = I1[1]; I1[0] = I2[0]; I1[1] = I2[1];
#pragma unroll
        for (int i = 0; i < 4; ++i) C0[i] = C1[i];
    }
    __syncthreads();
#undef PB_IDS
#undef PB_CFS
#undef PB_ID
#undef PB_LD8
#undef PB_WR8
#undef PB_STEP
}

__device__ __forceinline__ void peer_ln_phase(const Ctx& F, const bf16_t* __restrict__ y2, const float* __restrict__ lg, const float* __restrict__ lb, const float* __restrict__ modnext  ,
                                              float* __restrict__ xout32  , bf16_t* __restrict__ xout16, bf16_t* __restrict__ hout  , float* __restrict__ hsc) {
    LAS float* lv = (LAS float*)F.lds;
    lds_copy_vec(F, lv, lg, 2048); lds_copy_vec(F, lv + 2048, lb, 2048);
    if (modnext) { lds_copy_vec(F, lv + 4096, modnext, 4096); lds_copy_vec(F, lv + 8192, modnext + 6144, 4096); }
    __syncthreads();
    for (int t = F.bid * NWAVES + F.wave; t < NTOK; t += F.G * NWAVES) {
        float v[32]; row_load_bf16(y2 + (size_t)t * DM, F.lane, v);
        row_norm(v); row_affine_lds(v, lv, lv + 2048, F.lane);
        if (xout32) row_store_f32(xout32 + (size_t)t * DM, F.lane, v); else row_store_bf16(xout16 + (size_t)t * DM, F.lane, v);
        if (modnext) { const LAS float* mr = lv + 4096 + (t / SEQ) * 4096; row_norm(v); row_modulate_lds(v, mr, mr + 2048, F.lane); row_store_i8((signed char*)hout + (size_t)t * DM, hsc + t, F.lane, v); }
    }
    __syncthreads();
#if PEER_SELFTEST
    if (xout32 && F.bid == 0 && F.wave == 0) {
        constexpr int GA = 1, JA = 20;
        i32x8 At = {0, 0, 0, 0, 0, 0, 0, 0}; At[JA >> 3] = ((F.lane >> 4) == GA) ? (0x2 << (4 * (JA & 7))) : 0;
        float one = 1.0f; asm volatile("" : "+v"(one));
        const int w8 = __builtin_amdgcn_cvt_pk_fp8_f32(one, one, 0, false) & 0xFF;
        int found = -1, nm = 0;
#pragma unroll 1
        for (int gb = 0; gb < 4; ++gb) {
#pragma unroll
            for (int jb = 0; jb < 32; ++jb) {
                i32x8 Bt = {0, 0, 0, 0, 0, 0, 0, 0}; Bt[jb >> 2] = ((F.lane >> 4) == gb) ? (w8 << (8 * (jb & 3))) : 0;
                f32x4 d = {0.f, 0.f, 0.f, 0.f};
                d = __builtin_amdgcn_mfma_scale_f32_16x16x128_f8f6f4(At, Bt, d, 4, 0, 0, 0x7F7F7F7F, 0, 0x7F7F7F7F);
                const float tot = wave_sum(fabsf(d[0]) + fabsf(d[1]) + fabsf(d[2]) + fabsf(d[3]));
                if (tot != 0.f) { found = gb * 32 + jb; nm += 1; }
            }
        }
        if (F.lane == 0) xout32[0] = (float)(10 * (1 + (found >> 3)) + (nm > 1 ? 500 : 0));
    }
    __syncthreads();
#endif
}
#undef PEER_IDS
#undef PEER_ID
#undef PEER_LD8
#undef PEER_SC8
#undef PEER_ZERO4
#undef PEER_COPY4

constexpr int LDS_PARAMS = LDS_BYTES - 256;
__device__ __forceinline__ unsigned long long ld_param(LAS unsigned char* lds, int k) {
    const u32x2 v = *(volatile LAS u32x2*)(lds + LDS_PARAMS + 8 * k);
    const unsigned lo = __builtin_amdgcn_readfirstlane(v.x), hi = __builtin_amdgcn_readfirstlane(v.y);
    return ((unsigned long long)hi << 32) | lo;
}
template <class T> struct rm_ptr; template <class T> struct rm_ptr<T*> { typedef T type; };
template <class P> __device__ __forceinline__ P as_global(unsigned long long v) { typedef typename rm_ptr<P>::type T; return (P)(__attribute__((address_space(1))) T*)v; }
#define PARG(T, k) as_global<T>(ld_param(F.lds, (k)))
constexpr int N_PHASES = 3 + 2 * (7 + 6) + 2 * (7 + 6);

__global__ __launch_bounds__(NTHREADS, 2) void mega(Params p, int lo, int hi) {
    extern __shared__ __attribute__((aligned(16))) unsigned char lds_raw[];
    volatile LAS unsigned* misc = (volatile LAS unsigned*)((LAS unsigned char*)lds_raw + LDS_BYTES - 64);
    if (threadIdx.x < 4) misc[threadIdx.x] = 0u;
    if (threadIdx.x < 22) ((LAS unsigned long long*)((LAS unsigned char*)lds_raw + LDS_PARAMS))[threadIdx.x] = ((const __attribute__((address_space(4))) unsigned long long*)__builtin_amdgcn_kernarg_segment_ptr())[threadIdx.x];
    const int wave0 = __builtin_amdgcn_readfirstlane(threadIdx.x >> 6);
    __syncthreads();
    if (hi - lo > 1) (void)xcd_barrier_post((unsigned*)ld_param((LAS unsigned char*)lds_raw, 21), misc);
#define GRID_BARRIER() do { unsigned zb_ = 0u; asm volatile("" : "+v"(zb_)); XcdBarrier bar_; bar_.bar = (unsigned*)ld_param((LAS unsigned char*)lds_raw, 21); bar_.x = xb_xcc_id(); bar_.st = misc; xcd_barrier(bar_, wave0 == 0 && __builtin_amdgcn_mbcnt_hi(~0u, __builtin_amdgcn_mbcnt_lo(~0u, zb_)) == 0u); } while (0)

#define modp   ((float*)(ws + WS_MODP))
#define mod    ((float*)(ws + WS_MOD))
#define tw     ((float2*)(ws + WS_TW))
#define rope   ((float2*)(ws + WS_ROPE))
#define w_fpin ((bf16_t*)(ws + WS_WFPIN))
#define w_fpout ((bf16_t*)(ws + WS_WFPOUT))
#define w_atin ((bf16_t*)(ws + WS_WATIN))
#define w_atout ((bf16_t*)(ws + WS_WATOUT))
#define w_pq   ((bf16_t*)(ws + WS_WPQ))
#define w_fw   ((bf16_t*)(ws + WS_WFW))
#define w_pw   ((bf16_t*)(ws + WS_WPW))
#define w_sk   ((bf16_t*)(ws + WS_WSK))
#define w_sc   ((bf16_t*)(ws + WS_WSC))
#define kcb    ((bf16_t*)(ws + WS_KC))
#define vcb    ((bf16_t*)(ws + WS_VC))
#define u8b    ((unsigned char*)(ws + WS_UB))
#define v8b    ((unsigned char*)(ws + WS_VB))
#define su_    ((bf16_t*)(ws + WS_SU))
#define sv_    ((bf16_t*)(ws + WS_SV))
#define h8b    ((unsigned char*)(ws + WS_H8))
#define hs_    ((float*)(ws + WS_HS))
#define xa     ((bf16_t*)(ws + WS_XA))
#define xu     ((bf16_t*)(ws + WS_XU))
#define hbuf   ((bf16_t*)(ws + WS_H))
#define proj   ((bf16_t*)(ws + WS_PROJ))
#define ymix   ((bf16_t*)(ws + WS_YMIX))
#define pq     ((float*)(ws + WS_PQ))
#define yr     ((float*)(ws + WS_YR))
#define yi     ((float*)(ws + WS_YI))
#define pbuf   ((bf16_t*)(ws + WS_PBUF))
#define qp     ((bf16_t*)(ws + WS_QP))
#define eidx   ((int*)(ws + WS_EIDX))
#define eg     ((float*)(ws + WS_EG))
#define lns_   ((float*)(ws + WS_LNS))
#define coef_  ((float*)(ws + WS_COEF))
#define pw_    ((bf16_t*)(ws + WS_PW))
#define wsc8_  ((signed char*)(ws + WS_WSC8))
#define wss_   ((float*)(ws + WS_WSS))
#define win8_  ((signed char*)(ws + WS_WIN8))
#define wins_  ((float*)(ws + WS_WINS))
#define hs2_   ((float*)(ws + WS_HS2))
#define wout8_ ((signed char*)(ws + WS_WOUT8))
#define wouts_ ((float*)(ws + WS_WOUTS))
#define ys_    ((float*)(ws + WS_YS))
    int ph = 0;
#ifndef SITE_MASK
#define SITE_MASK 0xFFFFFFFFu
#endif
#ifndef PROBE_P0
#define PROBE_P0 0
#endif
#ifndef PROBE_REPEAT_MASK
#define PROBE_REPEAT_MASK 0u
#endif
#define PH_BEGIN(id) if ((((SITE_MASK) >> (id)) & 1u) && ph >= lo && ph < hi) { for (int rep_ = ((((PROBE_REPEAT_MASK) >> (id)) & 1u) ? 0 : 1); rep_ < 2; ++rep_) { if (rep_ == 1 && ((((PROBE_REPEAT_MASK) >> (id)) & 1u))) __syncthreads(); \
        Ctx F; F.lds = (LAS unsigned char*)lds_raw; { unsigned z_ = 0u; asm volatile("" : "+v"(z_)); F.lane = (int)__builtin_amdgcn_mbcnt_hi(~0u, __builtin_amdgcn_mbcnt_lo(~0u, z_)); } F.wave = wave0; F.tid = wave0 * 64 + F.lane; \
        { int g_ = gridDim.x, b_ = blockIdx.x; asm volatile("" : "+s"(g_), "+s"(b_)); F.G = g_; F.bid = b_; } \
        unsigned char* ws = as_global<unsigned char*>(ld_param(F.lds, 21));
#define PH_END   } if (ph + 1 < hi) GRID_BARRIER(); } ++ph;

    PH_BEGIN(0)
        adaln_partial(F, PARG(const float*, 1), PARG(const float*, 2), modp);
        transpose_job(F, PARG(const float*, 6), w_fpin, 2048, 2048, 2);
        transpose_job(F, PARG(const float*, 10), w_fpout, 2048, 2048, 2);
        transpose_job(F, PARG(const float*, 11), w_atin, 2048, 4608, 2);
        transpose_job(F, PARG(const float*, 15), w_atout, 2048, 2048, 2);
        cvt_stream(F, PARG(const float*, 16), w_pq, (size_t)4 * 2048 * 2048 / 8);
        transpose_job(F, PARG(const float*, 8), w_pw, 256, 256, 8);
        fourier_weights(F, PARG(const float*, 7), w_fw);
        make_tables(F, tw, rope);
        make_subkeys(F, PARG(const float*, 17), w_sk);
        quant4_rows<true>(F, PARG(const float*, 18), u8b, su_, 4 * NEXP);
        quant_fp4_rows(F, PARG(const float*, 19), v8b, sv_, 4 * NEXP);
#if PROBE_P0 == 1
        quant4_rows<true>(F, PARG(const float*, 18), u8b, su_, 4 * NEXP);
        quant_fp4_rows(F, PARG(const float*, 19), v8b, sv_, 4 * NEXP);
#endif
    PH_END
    PH_BEGIN(1)
        adaln_reduce(F, modp, PARG(const float*, 3), mod);
        { pg8::StaticOrder S; S.init(32, 8, F.G, F.bid);
          pg8::ScoreFoldOps O{w_sk, w_pq};
          pg8::EpiBf16 E{w_sc, DM, 0, nullptr};
          pg8::gemm_phase(F.tid, F.lds, 256, O, S, E); }
    PH_END
    PH_BEGIN(2)
        ln_mod_phase(F, PARG(const float*, 0), mod, (signed char*)hbuf, hs2_);
        quant_wsc_rows(F, w_sc, wsc8_, wss_, 4 * 2048);
        quant_wsc_rows(F, w_fpin, win8_, wins_, 2 * 2048);
        quant_wsc_rows(F, w_atin, win8_ + (size_t)2 * 2048 * 2048, wins_ + 2 * 2048, 2 * 4608);
        quant_wsc_rows(F, w_fpout, wout8_, wouts_, 2 * 2048);
        quant_wsc_rows(F, w_atout, wout8_ + (size_t)2 * 2048 * 2048, wouts_ + 2 * 2048, 2 * 2048);
    PH_END

#pragma clang loop unroll(full)
    for (int l = 0; l < DEPTH; ++l) {
        const int i = l >> 1;
        if ((l & 1) == 0) {
            PH_BEGIN(3)
                pg8::StaticOrder S; S.init(NTOK / 256, 8, F.G, F.bid);
                pg8::PlainOps O{hbuf, (const bf16_t*)(win8_ + (size_t)i * 2048 * 2048), DM / 2, DM / 2};
                pg8::EpiI8Score E{proj, DM, hs2_, wins_ + (size_t)i * 2048};
                pg8::gemm_phase<pg8::EpiI8Score, pg8::PlainOps, true>(F.tid, F.lds, DM / 2, O, S, E);
            PH_END
            PH_BEGIN(4)
                pg8::StaticOrder S; S.init(NTOK / 256, 8, F.G, F.bid);
                pg8::GroupOps O{proj, w_fw + (size_t)i * 4 * 512 * 256, DM, 256, 2, 256};
                pg8::EpiBf16 E{(bf16_t*)pq, DM, 0, nullptr};
                pg8::gemm_phase(F.tid, F.lds, 256, O, S, E);
                pool_phase(F, proj, pbuf);
            PH_END
            PH_BEGIN(5)
                dft1_phase(F, (const bf16_t*)pq, tw, (bf16_t*)yr, (bf16_t*)yi);
                pg8::StaticOrder S; S.init(NTOK / 256, 4, F.G, F.bid);
                pg8::GroupOps O{pbuf, w_pw + (size_t)i * 4 * 256 * 256, 1024, 256, 1, 256};
                pg8::EpiBf16 E{ymix, DM, 1024, PARG(const float*, 9) + (size_t)i * 1024};
                pg8::gemm_phase(F.tid, F.lds, 256, O, S, E);
            PH_END
            PH_BEGIN(6)
                dft2_phase(F, (const bf16_t*)yr, (const bf16_t*)yi, ymix);
            PH_END
            PH_BEGIN(21)
                quant_rows_phase(F, ymix, (signed char*)pbuf, ys_);
            PH_END
            PH_BEGIN(7)
                pg8::StaticOrder S; S.init(NTOK / 256, 8, F.G, F.bid);
                pg8::PlainOps O{pbuf, (const bf16_t*)(wout8_ + (size_t)i * 2048 * 2048), DM / 2, DM / 2};
                if (l == 0) { pg8::EpiResid<false, true> E{xu, PARG(const float*, 0), mod + (size_t)(l * 2) * 2 * 6144 + 4096, ys_, wouts_ + (size_t)i * 2048}; pg8::gemm_phase<pg8::EpiResid<false, true>, pg8::PlainOps, true>(F.tid, F.lds, DM / 2, O, S, E); }
                else { pg8::EpiResid<true, true> E{xu, xa, mod + (size_t)(l * 2) * 2 * 6144 + 4096, ys_, wouts_ + (size_t)i * 2048}; pg8::gemm_phase<pg8::EpiResid<true, true>, pg8::PlainOps, true>(F.tid, F.lds, DM / 2, O, S, E); }
            PH_END
        } else {
            PH_BEGIN(8)
                pg8::StaticOrder S; S.init(NTOK / 256, 16, F.G, F.bid);
                pg8::PlainOps O{hbuf, (const bf16_t*)(win8_ + (size_t)2 * 2048 * 2048 + (size_t)i * 4608 * 2048), DM / 2, DM / 2};
                pg8::EpiI8Score E{proj, ATT_IN, hs2_, wins_ + 2 * 2048 + (size_t)i * 4608};
                pg8::gemm_phase<pg8::EpiI8Score, pg8::PlainOps, true>(F.tid, F.lds, DM / 2, O, S, E);
            PH_END
            PH_BEGIN(9)
                const int half = F.G >> 1;
                if (F.bid < half) {
                    pg8::StaticOrder S; S.init(NTOK / 256, 2, half, F.bid);
                    pg8::PlainOps O{hbuf, (const bf16_t*)(win8_ + (size_t)2 * 2048 * 2048 + (size_t)i * 4608 * 2048 + (size_t)4096 * 2048), DM / 2, DM / 2};
                    pg8::EpiI8Score E{proj + 4096, ATT_IN, hs2_, wins_ + 2 * 2048 + (size_t)i * 4608 + 4096};
                    pg8::gemm_phase<pg8::EpiI8Score, pg8::PlainOps, true>(F.tid, F.lds, DM / 2, O, S, E);
                } else {
                    Ctx F2 = F; F2.bid = F.bid - half; F2.G = F.G - half;
                    qk_norm_rope_phase(F2, proj, PARG(const float*, 12) + i * 128, PARG(const float*, 13) + i * 128, rope, kcb, vcb);
                }
            PH_END
            PH_BEGIN(10)
                for (int it = F.bid; it < 2 * 8 * 32; it += F.G) {
                    const int hq = it & 7, qb = (it >> 3) & 31, b = it >> 8, kvh = hq >> 2;
                    const bf16_t* Q = proj + ((size_t)b * SEQ + qb * 256) * ATT_IN + hq * 128;
                    const bf16_t* Kp = kcb + (size_t)(b * 2 + kvh) * SEQ * 128;
                    const bf16_t* Vp = vcb + (size_t)(b * 2 + kvh) * SEQ * 128;
                    bf16_t* Op = ymix + ((size_t)b * SEQ + qb * 256) * DM + hq * 128;
                    att::attn_dense_body(Q, Kp, Vp, Op, SEQ, (char*)lds_raw, F.tid);
                }
            PH_END
            PH_BEGIN(17)
                natten_mfma_phase(F, proj, PARG(const float*, 14) + (size_t)i * 8 * 15 * 31, ymix);
            PH_END
            PH_BEGIN(21)
                quant_rows_phase(F, ymix, (signed char*)pbuf, ys_);
            PH_END
            PH_BEGIN(11)
                pg8::StaticOrder S; S.init(NTOK / 256, 8, F.G, F.bid);
                pg8::PlainOps O{pbuf, (const bf16_t*)(wout8_ + (size_t)(2 + i) * 2048 * 2048), DM / 2, DM / 2};
                if (l == 0) { pg8::EpiResid<false, true> E{xu, PARG(const float*, 0), mod + (size_t)(l * 2) * 2 * 6144 + 4096, ys_, wouts_ + (size_t)(2 + i) * 2048}; pg8::gemm_phase<pg8::EpiResid<false, true>, pg8::PlainOps, true>(F.tid, F.lds, DM / 2, O, S, E); }
                else { pg8::EpiResid<true, true> E{xu, xa, mod + (size_t)(l * 2) * 2 * 6144 + 4096, ys_, wouts_ + (size_t)(2 + i) * 2048}; pg8::gemm_phase<pg8::EpiResid<true, true>, pg8::PlainOps, true>(F.tid, F.lds, DM / 2, O, S, E); }
            PH_END
        }
        PH_BEGIN(12)
            ln2_phase(F, xu, PARG(const float*, 4) + (size_t)(l * 2) * DM, PARG(const float*, 5) + (size_t)(l * 2) * DM, mod + (size_t)(l * 2 + 1) * 2 * 6144, (signed char*)hbuf, h8b, hs_, lns_);
        PH_END
        PH_BEGIN(13)
            pg8::StaticOrder S; S.init(NTOK / 256, 8, F.G, F.bid);
            pg8::PlainOps O{hbuf, (const bf16_t*)(wsc8_ + (size_t)l * 2048 * 2048), DM / 2, DM / 2};
            pg8::EpiI8Score E{(bf16_t*)pq, DM, hs_, wss_ + (size_t)l * 2048};
            pg8::gemm_phase<pg8::EpiI8Score, pg8::PlainOps, true>(F.tid, F.lds, DM / 2, O, S, E);
        PH_END
        PH_BEGIN(15)
            topk_phase(F, (const bf16_t*)pq, eidx, eg);
        PH_END
        PH_BEGIN(16)
            peer_dots_phase(F, h8b, eidx, u8b + (size_t)l * NEXP * 1024, su_ + (size_t)l * NEXP * 32, (float*)qp);
        PH_END
        PH_BEGIN(18)
            peer_coef_phase(F, (const float*)qp, hs_, eg, eidx, sv_ + (size_t)l * NEXP * 8, (unsigned short*)coef_, (unsigned char*)pw_, (unsigned*)((unsigned char*)pw_ + (size_t)NTOK * 1024));
        PH_END
        PH_BEGIN(19)
            peer_acc_phase(F, (const unsigned short*)coef_, (const unsigned char*)pw_, (const unsigned*)((const unsigned char*)pw_ + (size_t)NTOK * 1024), v8b + (size_t)l * NEXP * 1024, xu, lns_,
                           PARG(const float*, 4) + (size_t)(l * 2) * DM, PARG(const float*, 5) + (size_t)(l * 2) * DM, mod + (size_t)(l * 2 + 1) * 2 * 6144 + 4096, ymix);
        PH_END
        PH_BEGIN(20)
            const bool lastl = (l == DEPTH - 1);
            peer_ln_phase(F, ymix, PARG(const float*, 4) + (size_t)(l * 2 + 1) * DM, PARG(const float*, 5) + (size_t)(l * 2 + 1) * DM,
                          lastl ? nullptr : mod + (size_t)((l + 1) * 2) * 2 * 6144, lastl ? PARG(float*, 20) : (float*)nullptr, xa, hbuf, hs2_);
        PH_END
    }
#undef PH_BEGIN
#undef PH_END
}

extern "C" void kernel_launch(void* const* d_in, const int* in_sizes, int n_in, void* d_out, int out_size, void* d_ws, size_t ws_size, hipStream_t stream) {
    static int grid = 0;
    if (grid == 0) {
        if (n_in != 20 || out_size != NTOK * DM || ws_size < WS_END) { fprintf(stderr, "kernel_launch: unexpected shapes: n_in %d out %d ws %zu (need %zu)\n", n_in, out_size, ws_size, (size_t)WS_END); grid = -1; return; }
        int dev = 0, cus = 0, per_cu = 0;
        if (hipGetDevice(&dev) != hipSuccess || hipDeviceGetAttribute(&cus, hipDeviceAttributeMultiprocessorCount, dev) != hipSuccess) { grid = -1; return; }
        if (hipFuncSetAttribute((const void*)mega, hipFuncAttributeMaxDynamicSharedMemorySize, LDS_BYTES) != hipSuccess) { fprintf(stderr, "kernel_launch: hipFuncSetAttribute failed\n"); grid = -1; return; }
        if (hipOccupancyMaxActiveBlocksPerMultiprocessor(&per_cu, (const void*)mega, NTHREADS, LDS_BYTES) != hipSuccess || per_cu < 1) fprintf(stderr, "kernel_launch: occupancy query reports %d\n", per_cu);
        (void)hipGetLastError();
        grid = cus;
    }
    if (grid < 0) return;
    hipMemsetAsync((char*)d_ws + WS_BAR, 0, 16384, stream);
    Params p{};
    const float** pp = (const float**)&p;
    for (int i = 0; i < 20; ++i) pp[i] = (const float*)d_in[i];
    p.out = (float*)d_out; p.ws = (unsigned char*)d_ws;
#if MK_SINGLE_LAUNCH
    hipLaunchKernelGGL(mega, dim3(grid), dim3(NTHREADS), LDS_BYTES, stream, p, 0, N_PHASES);
#else
    for (int k = 0; k < N_PHASES; ++k) hipLaunchKernelGGL(mega, dim3(grid), dim3(NTHREADS), LDS_BYTES, stream, p, k, k + 1);
#endif
}
```

```cpp
#include <hip/hip_runtime.h>
#include <cstdio>
#include <cstdint>

#ifndef MK_SINGLE_LAUNCH
#define MK_SINGLE_LAUNCH 1
#endif

#define LAS __attribute__((address_space(3)))
typedef unsigned short bf16_t;
typedef short bf16x8 __attribute__((ext_vector_type(8)));
typedef short s16x4 __attribute__((ext_vector_type(4)));
typedef float f32x4 __attribute__((ext_vector_type(4)));
typedef float f32x2 __attribute__((ext_vector_type(2)));
typedef float f32x8 __attribute__((ext_vector_type(8)));
typedef float f32x16 __attribute__((ext_vector_type(16)));
typedef unsigned u32x4 __attribute__((ext_vector_type(4)));
typedef unsigned u32x2 __attribute__((ext_vector_type(2)));

constexpr int DM = 2048, NBATCH = 2, SEQ = 8192, NTOK = NBATCH * SEQ, DEPTH = 4;
constexpr int ATT_IN = 4608;
constexpr int NEXP = 16384;
constexpr float ALPHA = 1.6817928305074290f;
constexpr float LN_EPS = 1e-6f;
constexpr float ATT_SCALE = 0.088388347648318440f;
constexpr float FOURIER_SCALE = 6.9053396600248786e-4f;
constexpr int NTHREADS = 512, NWAVES = 8;
constexpr int LDS_BYTES = 147456;

constexpr size_t al256(size_t x) { return (x + 255) / 256 * 256; }
constexpr size_t WS_BAR   = 0;
constexpr size_t WS_MODP  = 16384;
constexpr size_t WS_MOD   = WS_MODP + (size_t)8 * 32 * 2 * 6144 * 4;
constexpr size_t WS_TW    = WS_MOD + (size_t)8 * 2 * 6144 * 4;
constexpr size_t WS_ROPE  = WS_TW + 8192 * 8;
constexpr size_t WS_WFPIN = WS_ROPE + 128 * 32 * 8;
constexpr size_t WS_WFPOUT= WS_WFPIN + (size_t)2 * 2048 * 2048 * 2;
constexpr size_t WS_WATIN = WS_WFPOUT + (size_t)2 * 2048 * 2048 * 2;
constexpr size_t WS_WATOUT= WS_WATIN + (size_t)2 * 4608 * 2048 * 2;
constexpr size_t WS_WPQ   = WS_WATOUT + (size_t)2 * 2048 * 2048 * 2;
constexpr size_t WS_WFW   = WS_WPQ + (size_t)4 * 2048 * 2048 * 2;
constexpr size_t WS_WPW   = WS_WFW + (size_t)2 * 4 * 512 * 256 * 2;
constexpr size_t WS_WSK   = WS_WPW + (size_t)2 * 4 * 256 * 256 * 2;
constexpr size_t WS_UB    = WS_WSK + (size_t)4 * 8 * 256 * 256 * 2;
constexpr size_t WS_VB    = WS_UB + (size_t)4 * NEXP * 1024;
constexpr size_t WS_SU    = WS_VB + (size_t)4 * NEXP * 1024;
constexpr size_t WS_SV    = WS_SU + (size_t)4 * NEXP * 64 * 2;
constexpr size_t WS_H8    = WS_SV + (size_t)4 * NEXP * 64 * 2;
constexpr size_t WS_HS    = WS_H8 + (size_t)NTOK * DM;
constexpr size_t WS_XA    = WS_HS + (size_t)NTOK * 4;
constexpr size_t WS_XU    = WS_XA + (size_t)NTOK * DM * 4;
constexpr size_t WS_H     = WS_XU + (size_t)NTOK * DM * 4;
constexpr size_t WS_PROJ  = WS_H + (size_t)NTOK * DM * 2;
constexpr size_t WS_YMIX  = WS_PROJ + (size_t)NTOK * ATT_IN * 2;
constexpr size_t WS_PQ    = WS_YMIX + (size_t)NTOK * DM * 2;
constexpr size_t WS_YR    = WS_PQ + (size_t)NTOK * DM * 4;
constexpr size_t WS_YI    = WS_YR + (size_t)NTOK * 1024 * 4;
constexpr size_t WS_PBUF  = WS_YI + (size_t)NTOK * 1024 * 4;
constexpr size_t WS_QP    = WS_PBUF + (size_t)NTOK * 1024 * 2;
constexpr size_t WS_EIDX  = WS_QP + (size_t)NTOK * DM * 2;
constexpr size_t WS_EG    = WS_EIDX + (size_t)NTOK * 128 * 4;
constexpr size_t WS_WSC   = WS_EG + (size_t)NTOK * 128 * 4;
constexpr size_t WS_KC    = WS_WSC + (size_t)4 * 2048 * 2048 * 2;
constexpr size_t WS_VC    = WS_KC + (size_t)NTOK * 256 * 2;
constexpr size_t WS_LNS   = WS_VC + (size_t)NTOK * 256 * 2;
constexpr size_t WS_COEF  = WS_LNS + (size_t)NTOK * 2 * 4;
constexpr size_t WS_PW    = WS_COEF + (size_t)NTOK * 128 * 4;
constexpr size_t WS_WSC8  = WS_PW + (size_t)NTOK * 8 * 128 * 2;
constexpr size_t WS_WSS   = WS_WSC8 + (size_t)4 * 2048 * 2048;
constexpr size_t WS_WIN8  = WS_WSS + (size_t)4 * 2048 * 4;
constexpr size_t WS_WINS  = WS_WIN8 + (size_t)(2 * 2048 + 2 * 4608) * 2048;
constexpr size_t WS_HS2   = WS_WINS + (size_t)(2 * 2048 + 2 * 4608) * 4;
constexpr size_t WS_WOUT8 = WS_HS2 + (size_t)NTOK * 4;
constexpr size_t WS_WOUTS = WS_WOUT8 + (size_t)4 * 2048 * 2048;
constexpr size_t WS_YS    = WS_WOUTS + (size_t)4 * 2048 * 4;
constexpr size_t WS_END   = WS_YS + (size_t)NTOK * 4;

struct Params {
    const float *x, *c, *ada_w, *ada_b, *ln_g, *ln_b, *fp_w_in, *fp_w_fourier, *fp_w_pool, *fp_pool_scale, *fp_w_out;
    const float *at_w_in, *at_q_norm, *at_k_norm, *at_rpb, *at_w_out, *peer_w_q, *peer_sub_keys, *peer_u, *peer_v;
    float* out; unsigned char* ws;
};

__device__ __forceinline__ float bf2f(bf16_t v) { return __uint_as_float(((unsigned)v) << 16); }
__device__ __forceinline__ float bflo(unsigned w) { return __uint_as_float(w << 16); }
__device__ __forceinline__ float bfhi(unsigned w) { return __uint_as_float(w & 0xffff0000u); }
__device__ __forceinline__ unsigned cvt_pk_bf16(float lo, float hi) { unsigned r; asm volatile("v_cvt_pk_bf16_f32 %0, %1, %2" : "=v"(r) : "v"(lo), "v"(hi)); return r; }
__device__ __forceinline__ bf16_t f2bf(float f) { return (bf16_t)(cvt_pk_bf16(f, 0.f) & 0xffffu); }
#define DPPF(v, ctrl) __int_as_float(__builtin_amdgcn_update_dpp(0, __float_as_int(v), (ctrl), 0xF, 0xF, true))
#define RDL(v, l) __int_as_float(__builtin_amdgcn_readlane(__float_as_int(v), (l)))
__device__ __forceinline__ float wave_sum(float v) {
    v += DPPF(v, 0xB1); v += DPPF(v, 0x4E); v += DPPF(v, 0x141); v += DPPF(v, 0x140);
    return (RDL(v, 0) + RDL(v, 16)) + (RDL(v, 32) + RDL(v, 48));
}
__device__ __forceinline__ float wave_max(float v) {
    v = fmaxf(v, DPPF(v, 0xB1)); v = fmaxf(v, DPPF(v, 0x4E)); v = fmaxf(v, DPPF(v, 0x141)); v = fmaxf(v, DPPF(v, 0x140));
    return fmaxf(fmaxf(RDL(v, 0), RDL(v, 16)), fmaxf(RDL(v, 32), RDL(v, 48)));
}
__device__ __forceinline__ float gelu_erf(float v) { return 0.5f * v * (1.0f + erff(v * 0.70710678118654752f)); }

#define XB_TMO      128
#define XB_XCNT(j)  (256  + 64 * (j))
#define XB_XSUB(j)  (1280 + 64 * (j))
#define XB_XGEN(j)  (2304 + 64 * (j))
#define XB_TOP      3328
#define XB_TOPGEN   3392
#define XCD_BAR_WORDS 3456
#define XB_SPIN_CAP (1u << 18)

__device__ __forceinline__ unsigned xb_ld(unsigned* p)              { return __hip_atomic_load(p, __ATOMIC_RELAXED, __HIP_MEMORY_SCOPE_AGENT); }
__device__ __forceinline__ unsigned xb_add(unsigned* p, unsigned v) { return __hip_atomic_fetch_add(p, v, __ATOMIC_RELAXED, __HIP_MEMORY_SCOPE_AGENT); }
__device__ __forceinline__ unsigned xb_xcc_id() { return (unsigned)__builtin_amdgcn_s_getreg((3 << 11) | 20) & 0xFu; }
#define XB_SPIN(cond, bar) do { unsigned _sp = 0; while (cond) { __builtin_amdgcn_s_sleep(1); \
    if ((++_sp & 255u) == 0u) { if (xb_ld(&(bar)[XB_TMO])) break; if (_sp > XB_SPIN_CAP) { atomicAdd(&(bar)[XB_TMO], 1u); break; } } } } while (0)

struct XcdBarrier { unsigned* bar; unsigned x; volatile LAS unsigned* st; };

__device__ __forceinline__ XcdBarrier xcd_barrier_post(unsigned* bar, volatile LAS unsigned* st) {
    XcdBarrier b; b.bar = bar; b.x = xb_xcc_id(); b.st = st;
    if (threadIdx.x == 0) (void)xb_add(&bar[XB_XCNT(b.x)], 1u);
    return b;
}
__device__ __forceinline__ void xcd_barrier_complete(unsigned* bar, unsigned x, unsigned& nloc, unsigned& nx) {
    const unsigned G = gridDim.x * gridDim.y * gridDim.z;
    unsigned sum, cnt, mine, sp = 0u;
    for (;;) {
        sum = 0u; cnt = 0u; mine = 0u;
#pragma unroll
        for (unsigned j = 0; j < 16; ++j) { const unsigned c = xb_ld(&bar[XB_XCNT(j)]); sum += c; cnt += (c > 0u) ? 1u : 0u; mine = (j == x) ? c : mine; }
        if (sum == G) break;
        __builtin_amdgcn_s_sleep(1);
        if ((++sp & 255u) == 0u) { if (xb_ld(&bar[XB_TMO])) break; if (sp > XB_SPIN_CAP) { atomicAdd(&bar[XB_TMO], 1u); break; } }
    }
    nloc = mine > 0u ? mine : 1u; nx = cnt > 0u ? cnt : 1u;
}
__device__ __forceinline__ void xcd_barrier(const XcdBarrier& b, const bool leader) {
    asm volatile("s_waitcnt vmcnt(0)" ::: "memory");
    __syncthreads();
    if (leader) {
        unsigned* bar = b.bar;
        __builtin_amdgcn_s_waitcnt(0);
        unsigned nloc = b.st[0], nx = b.st[1];
        if (nloc == 0u) { xcd_barrier_complete(bar, b.x, nloc, nx); b.st[0] = nloc; b.st[1] = nx; }
        const unsigned old = xb_add(&bar[XB_XSUB(b.x)], 1u);
        const unsigned gen = old / nloc;
        if (old + 1u == (gen + 1u) * nloc) {
            __builtin_amdgcn_fence(__ATOMIC_RELEASE, "agent");
            asm volatile("s_waitcnt vmcnt(0)" ::: "memory");
            const unsigned og = xb_add(&bar[XB_TOP], 1u);
            const unsigned tg = og / nx;
            if (og + 1u == (tg + 1u) * nx) xb_add(&bar[XB_TOPGEN], 1u);
            else XB_SPIN(xb_ld(&bar[XB_TOPGEN]) == tg, bar);
            __builtin_amdgcn_fence(__ATOMIC_ACQUIRE, "agent");
            xb_add(&bar[XB_XGEN(b.x)], 1u);
            asm volatile("s_waitcnt vmcnt(0)" ::: "memory");
        } else {
            XB_SPIN(xb_ld(&bar[XB_XGEN(b.x)]) == gen, bar);
            __builtin_amdgcn_fence(__ATOMIC_ACQUIRE, "agent");
            asm volatile("s_waitcnt vmcnt(0)" ::: "memory");
        }
    }
    __syncthreads();
}

namespace pg8 {
typedef int i32x4_t __attribute__((ext_vector_type(4)));
constexpr int BM = 256, BK = 64, HALF = 128, HTB = HALF * BK * 2, STAGE_BYTES = 8 * HTB, NXCD = 8, WGM = 4;
__host__ __device__ __forceinline__ int lds_byte(int r, int c) { const int st = (r >> 4) * 2 + (c >> 5), rr = r & 15, cc = c & 31, ob = rr * 64 + cc * 2; return st * 1024 + (ob ^ (((ob >> 9) & 1) << 5)); }
__host__ __device__ __forceinline__ void stage_rc(int b, int& R, int& C) { const int st = b / 1024, sb = b % 1024, swz = sb ^ (((sb >> 9) & 1) << 5); R = (st >> 1) * 16 + swz / 64; C = (st & 1) * 32 + (swz % 64) / 2; }
__host__ __device__ __forceinline__ int perm32(int rho) { const int n = rho >> 4, i = rho & 15; return 8 * (i >> 2) + 4 * n + (i & 3); }
struct Unit { int pm, pn; };
struct StaticOrder {
    int nM, nN, nwg, G, c;
    __device__ void init(int nM_, int nN_, int G_, int c_) { nM = nM_; nN = nN_; nwg = nM * nN; G = G_; c = c_; }
    __device__ bool next(int i, Unit& u) const {
        const long L = (long)i * G + c; if (L >= nwg) return false;
        int wgid = (int)L; { const int q = nwg / NXCD, r = nwg % NXCD, xcd = wgid % NXCD, off = wgid / NXCD; wgid = (xcd < r ? xcd * (q + 1) : r * (q + 1) + (xcd - r) * q) + off; }
        const int nig = WGM * nN, gid = wgid / nig, fm = gid * WGM, gsz = (nM - fm) < WGM ? (nM - fm) : WGM;
        u.pm = fm + ((wgid % nig) % gsz); u.pn = (wgid % nig) / gsz; return true;
    }
};
struct PlainOps {
    const bf16_t* A; const bf16_t* Bt; int lda, ldb;
    __device__ __forceinline__ const char* a(const Unit& u) const { return (const char*)(A + (size_t)u.pm * BM * lda); }
    __device__ __forceinline__ const char* b(const Unit& u) const { return (const char*)(Bt + (size_t)u.pn * BM * ldb); }
};
struct GroupOps {
    const bf16_t* A; const bf16_t* Bt; int lda, ldb, tpg, a_gstride;
    __device__ __forceinline__ const char* a(const Unit& u) const { return (const char*)(A + (size_t)u.pm * BM * lda + (size_t)(u.pn / tpg) * a_gstride); }
    __device__ __forceinline__ const char* b(const Unit& u) const { return (const char*)(Bt + (size_t)u.pn * BM * ldb); }
};

struct ScoreFoldOps {
    const bf16_t* A; const bf16_t* B;
    static constexpr int lda = 256, ldb = 2048;
    __device__ __forceinline__ const char* a(const Unit& u) const { return (const char*)(A + (size_t)u.pm * 65536); }
    __device__ __forceinline__ const char* b(const Unit& u) const { return (const char*)(B + (size_t)(u.pm >> 3) * 2048 * 2048 + (size_t)u.pn * BM * 2048 + (u.pm & 7) * 256); }
};
struct EpiF32 {
    static constexpr bool PERM = false;
    float* C; int ldc;
    __device__ __forceinline__ void operator()(const f32x4 (&acc)[2][2][4][2], const Unit& u, int wr, int wc, int fr, int fq) const {
        const int row0 = u.pm * BM + wr * 64 + fr, col0 = u.pn * BM + wc * 32 + 4 * fq;
#pragma unroll
        for (int ai = 0; ai < 2; ++ai)
#pragma unroll
            for (int m = 0; m < 4; ++m) { float* rowp = C + (size_t)(row0 + ai * HALF + m * 16) * ldc + col0;
#pragma unroll
                for (int bj = 0; bj < 2; ++bj)
#pragma unroll
                    for (int n = 0; n < 2; ++n) *(f32x4*)(rowp + bj * HALF + n * 16) = acc[ai][bj][m][n]; }
    }
};
template <bool XB  , bool I8 = false  >
struct EpiResid {
    static constexpr bool PERM = true;
    bf16_t* U; const void* X; const float* gate;
    const float* rowscale; const float* colscale;
    __device__ __forceinline__ void operator()(const f32x4 (&acc)[2][2][4][2], const Unit& u, int wr, int wc, int fr, int fq) const {
        const int row0 = u.pm * BM + wr * 64 + fr, col0 = u.pn * BM + wc * 32 + 8 * fq;
        const float* gp = gate + (size_t)((u.pm * BM) / SEQ) * 6144 + col0;
        f32x4 gv[2][2];
#pragma unroll
        for (int bj = 0; bj < 2; ++bj)
#pragma unroll
            for (int n = 0; n < 2; ++n) { gv[bj][n] = *(const f32x4*)(gp + bj * HALF + 4 * n); if constexpr (I8) gv[bj][n] *= *(const f32x4*)(colscale + col0 + bj * HALF + 4 * n); }
#pragma unroll
        for (int ai = 0; ai < 2; ++ai)
#pragma unroll
            for (int m = 0; m < 4; ++m) { const size_t ro = (size_t)(row0 + ai * HALF + m * 16) * DM + col0; float rs = 1.0f; if constexpr (I8) rs = rowscale[row0 + ai * HALF + m * 16];
#pragma unroll
                for (int bj = 0; bj < 2; ++bj) { f32x4 x0, x1;
                    if constexpr (XB) { const u32x4 xw = *(const u32x4*)((const bf16_t*)X + ro + bj * HALF); x0 = (f32x4){bflo(xw.x), bfhi(xw.x), bflo(xw.y), bfhi(xw.y)}; x1 = (f32x4){bflo(xw.z), bfhi(xw.z), bflo(xw.w), bfhi(xw.w)}; }
                    else { x0 = *(const f32x4*)((const float*)X + ro + bj * HALF); x1 = *(const f32x4*)((const float*)X + ro + bj * HALF + 4); }
                    f32x4 a0 = acc[ai][bj][m][0], a1 = acc[ai][bj][m][1];
                    if constexpr (I8) { const i32x4_t i0 = __builtin_bit_cast(i32x4_t, a0), i1 = __builtin_bit_cast(i32x4_t, a1);
                        a0 = (f32x4){(float)i0[0], (float)i0[1], (float)i0[2], (float)i0[3]} * rs; a1 = (f32x4){(float)i1[0], (float)i1[1], (float)i1[2], (float)i1[3]} * rs; }
                    const f32x4 r0 = x0 * ALPHA + gv[bj][0] * a0, r1 = x1 * ALPHA + gv[bj][1] * a1;
                    u32x4 w; w.x = cvt_pk_bf16(r0[0], r0[1]); w.y = cvt_pk_bf16(r0[2], r0[3]); w.z = cvt_pk_bf16(r1[0], r1[1]); w.w = cvt_pk_bf16(r1[2], r1[3]);
                    *(u32x4*)(U + ro + bj * HALF) = w; } }
    }
};
struct EpiI8Score {
    static constexpr bool PERM = true;
    bf16_t* O; int ldc; const float* rowscale; const float* colscale;
    __device__ __forceinline__ void operator()(const f32x4 (&acc)[2][2][4][2], const Unit& u, int wr, int wc, int fr, int fq) const {
        const int row0 = u.pm * BM + wr * 64 + fr, col0 = u.pn * BM + wc * 32 + 8 * fq;
        f32x4 sv[2][2];
#pragma unroll
        for (int bj = 0; bj < 2; ++bj)
#pragma unroll
            for (int n = 0; n < 2; ++n) sv[bj][n] = *(const f32x4*)(colscale + col0 + bj * HALF + 4 * n);
#pragma unroll
        for (int ai = 0; ai < 2; ++ai)
#pragma unroll
            for (int m = 0; m < 4; ++m) { const int row = row0 + ai * HALF + m * 16; const float rs = rowscale[row]; bf16_t* rowp = O + (size_t)row * ldc + col0;
#pragma unroll
                for (int bj = 0; bj < 2; ++bj) { const i32x4_t i0 = __builtin_bit_cast(i32x4_t, acc[ai][bj][m][0]), i1 = __builtin_bit_cast(i32x4_t, acc[ai][bj][m][1]);
                    const f32x4 s0 = sv[bj][0] * rs, s1 = sv[bj][1] * rs;
                    u32x4 w; w.x = cvt_pk_bf16((float)i0[0] * s0[0], (float)i0[1] * s0[1]); w.y = cvt_pk_bf16((float)i0[2] * s0[2], (float)i0[3] * s0[3]);
                    w.z = cvt_pk_bf16((float)i1[0] * s1[0], (float)i1[1] * s1[1]); w.w = cvt_pk_bf16((float)i1[2] * s1[2], (float)i1[3] * s1[3]);
                    *(u32x4*)(rowp + bj * HALF) = w; } }
    }
};
struct EpiBf16 {
    static constexpr bool PERM = true;
    bf16_t* O; int ldc; int coloff; const float* colscale;
    __device__ __forceinline__ void operator()(const f32x4 (&acc)[2][2][4][2], const Unit& u, int wr, int wc, int fr, int fq) const {
        const int row0 = u.pm * BM + wr * 64 + fr, col0 = u.pn * BM + wc * 32 + 8 * fq;
        f32x4 sv[2][2];
#pragma unroll
        for (int bj = 0; bj < 2; ++bj)
#pragma unroll
            for (int n = 0; n < 2; ++n) sv[bj][n] = colscale ? *(const f32x4*)(colscale + col0 + bj * HALF + 4 * n) : (f32x4){1.f, 1.f, 1.f, 1.f};
#pragma unroll
        for (int ai = 0; ai < 2; ++ai)
#pragma unroll
            for (int m = 0; m < 4; ++m) { bf16_t* rowp = O + (size_t)(row0 + ai * HALF + m * 16) * ldc + coloff + col0;
#pragma unroll
                for (int bj = 0; bj < 2; ++bj) { const f32x4 v0 = acc[ai][bj][m][0] * sv[bj][0], v1 = acc[ai][bj][m][1] * sv[bj][1];
                    u32x4 w; w.x = cvt_pk_bf16(v0[0], v0[1]); w.y = cvt_pk_bf16(v0[2], v0[3]); w.z = cvt_pk_bf16(v1[0], v1[1]); w.w = cvt_pk_bf16(v1[2], v1[3]);
                    *(u32x4*)(rowp + bj * HALF) = w; } }
    }
};

template <class Epi, class Ops, bool I8 = false>
__device__ __forceinline__ void gemm_phase(const int tid, LAS unsigned char* lds, const int K, const Ops& P, const StaticOrder& S, const Epi& E) {
    const int wid = __builtin_amdgcn_readfirstlane(tid >> 6), lane = tid & 63, wr = wid >> 2, wc = wid & 3, fr = lane & 15, fq = lane >> 4;
    const int nt = K / BK;
    unsigned voffA[2], voffB[2];
#pragma unroll
    for (int i = 0; i < 2; ++i) { int R, C; stage_rc(tid * 16 + i * 8192, R, C); const int Rb = Epi::PERM ? ((R & ~31) + perm32(R & 31)) : R;
        voffA[i] = (unsigned)(R * P.lda + C) * 2u; voffB[i] = (unsigned)(Rb * P.ldb + C) * 2u; }
    const size_t kstep = (size_t)(BK * 2);
    const size_t hstepA = (size_t)HALF * P.lda * 2, hstepB = (size_t)HALF * P.ldb * 2;
    const unsigned ldsw = (unsigned)wid * 1024u;
    const int aoff = lds_byte(wr * 64 + fr, fq * 8), boff = lds_byte(wc * 32 + fr, fq * 8);
#define PG8_SA(b, h) (((b) * 2 + (h)) * HTB)
#define PG8_SB(b, h) ((4 + (b) * 2 + (h)) * HTB)
#define PG8_STAGE(bufoff, gbase, voff) do { _Pragma("unroll") for (int _i = 0; _i < 2; ++_i) \
        __builtin_amdgcn_global_load_lds((const unsigned*)((const char*)(gbase) + (voff)[_i]), (LAS unsigned*)(lds + (bufoff) + ldsw + _i * 8192), 16, 0, 0); } while (0)
#define PG8_LDA(dst, b, h) do { _Pragma("unroll") for (int m = 0; m < 4; ++m) _Pragma("unroll") for (int k = 0; k < 2; ++k) dst[m][k] = *(const LAS bf16x8*)(lds + PG8_SA(b, h) + aoff + m * 2048 + k * 1024); } while (0)
#define PG8_LDB(dst, b, h) do { _Pragma("unroll") for (int n = 0; n < 2; ++n) _Pragma("unroll") for (int k = 0; k < 2; ++k) dst[n][k] = *(const LAS bf16x8*)(lds + PG8_SB(b, h) + boff + n * 2048 + k * 1024); } while (0)
#define PG8_MMA(ai, bj, At, Bt) do { __builtin_amdgcn_s_setprio(1); _Pragma("unroll") for (int m = 0; m < 4; ++m) _Pragma("unroll") for (int n = 0; n < 2; ++n) _Pragma("unroll") for (int k = 0; k < 2; ++k) \
        { if constexpr (I8) acc[ai][bj][m][n] = __builtin_bit_cast(f32x4, __builtin_amdgcn_mfma_i32_16x16x64_i8(__builtin_bit_cast(i32x4_t, Bt[n][k]), __builtin_bit_cast(i32x4_t, At[m][k]), __builtin_bit_cast(i32x4_t, acc[ai][bj][m][n]), 0, 0, 0)); \
          else acc[ai][bj][m][n] = __builtin_amdgcn_mfma_f32_16x16x32_bf16(Bt[n][k], At[m][k], acc[ai][bj][m][n], 0, 0, 0); } __builtin_amdgcn_s_setprio(0); } while (0)
#define PG8_WAIT_V(n) asm volatile("s_waitcnt vmcnt(" #n ")" ::: "memory")
#define PG8_WAIT_L(n) asm volatile("s_waitcnt lgkmcnt(" #n ")" ::: "memory")
#define PG8_BAR __builtin_amdgcn_s_barrier()
#define PG8_SCHED __builtin_amdgcn_sched_barrier(0)
    Unit cur, nxt; int ui = 0;
    if (!S.next(0, cur)) return;
    f32x4 acc[2][2][4][2];
#pragma unroll
    for (int a = 0; a < 2; ++a)
#pragma unroll
        for (int b = 0; b < 2; ++b)
#pragma unroll
            for (int m = 0; m < 4; ++m)
#pragma unroll
                for (int n = 0; n < 2; ++n) acc[a][b][m][n] = (f32x4){0.f, 0.f, 0.f, 0.f};
    bf16x8 At[4][2], B0[2][2], B1[2][2];
    const char* cA = P.a(cur); const char* cB = P.b(cur);
    PG8_STAGE(PG8_SB(0, 0), cB, voffB); PG8_STAGE(PG8_SA(0, 0), cA, voffA); PG8_STAGE(PG8_SB(0, 1), cB + hstepB, voffB); PG8_STAGE(PG8_SA(0, 1), cA + hstepA, voffA);
    if (wr == 1) PG8_BAR;
    PG8_WAIT_V(4); PG8_BAR;
    PG8_STAGE(PG8_SB(1, 0), cB + kstep, voffB); PG8_STAGE(PG8_SA(1, 0), cA + kstep, voffA); PG8_STAGE(PG8_SB(1, 1), cB + hstepB + kstep, voffB);
    PG8_WAIT_V(6); PG8_BAR;
    for (;;) {
        const bool has_next = S.next(ui + 1, nxt);
        const char* nA = has_next ? P.a(nxt) : cA; const char* nB = has_next ? P.b(nxt) : cB;
        for (int t = 0; t < nt; t += 2) {
            const bool last = (t == nt - 2);
            const char* a1 = cA + (size_t)(t + 1) * kstep;
            const char* a2 = last ? nA : cA + (size_t)(t + 2) * kstep; const char* b2 = last ? nB : cB + (size_t)(t + 2) * kstep;
            const char* a3 = a2 + kstep; const char* b3 = b2 + kstep;
            PG8_LDB(B0, 0, 0); PG8_SCHED; PG8_LDA(At, 0, 0); PG8_STAGE(PG8_SA(1, 1), a1 + hstepA, voffA);
            PG8_WAIT_L(8); PG8_BAR; PG8_WAIT_L(0); PG8_MMA(0, 0, At, B0); PG8_BAR; PG8_SCHED;
            PG8_LDB(B1, 0, 1); PG8_STAGE(PG8_SB(0, 0), b2, voffB);
            PG8_BAR; PG8_WAIT_L(0); PG8_MMA(0, 1, At, B1); PG8_BAR;
            PG8_LDA(At, 0, 1); PG8_STAGE(PG8_SA(0, 0), a2, voffA);
            PG8_BAR; PG8_WAIT_L(0); PG8_MMA(1, 0, At, B0); PG8_BAR; PG8_SCHED;
            PG8_STAGE(PG8_SB(0, 1), b2 + hstepB, voffB);
            PG8_WAIT_V(6); PG8_BAR; PG8_MMA(1, 1, At, B1); PG8_BAR;
            PG8_LDB(B0, 1, 0); PG8_SCHED; PG8_LDA(At, 1, 0); PG8_STAGE(PG8_SA(0, 1), a2 + hstepA, voffA);
            PG8_WAIT_L(8); PG8_BAR; PG8_WAIT_L(0); PG8_MMA(0, 0, At, B0); PG8_BAR; PG8_SCHED;
            PG8_LDB(B1, 1, 1); PG8_STAGE(PG8_SB(1, 0), b3, voffB);
            PG8_BAR; PG8_WAIT_L(0); PG8_MMA(0, 1, At, B1); PG8_BAR;
            PG8_LDA(At, 1, 1); PG8_STAGE(PG8_SA(1, 0), a3, voffA);
            PG8_BAR; PG8_WAIT_L(0); PG8_MMA(1, 0, At, B0); PG8_BAR; PG8_SCHED;
            PG8_STAGE(PG8_SB(1, 1), b3 + hstepB, voffB);
            PG8_WAIT_V(6); PG8_BAR; PG8_MMA(1, 1, At, B1); PG8_BAR;
        }
        E(acc, cur, wr, wc, fr, fq);
        if (!has_next) break;
#pragma unroll
        for (int a = 0; a < 2; ++a)
#pragma unroll
            for (int b = 0; b < 2; ++b)
#pragma unroll
                for (int m = 0; m < 4; ++m)
#pragma unroll
                    for (int n = 0; n < 2; ++n) acc[a][b][m][n] = (f32x4){0.f, 0.f, 0.f, 0.f};
        cur = nxt; cA = nA; cB = nB; ++ui;
    }
    PG8_WAIT_V(0);
    if (wr == 0) PG8_BAR;
    PG8_BAR;
#undef PG8_SA
#undef PG8_SB
#undef PG8_STAGE
#undef PG8_LDA
#undef PG8_LDB
#undef PG8_MMA
#undef PG8_WAIT_V
#undef PG8_WAIT_L
#undef PG8_BAR
#undef PG8_SCHED
}
}

namespace att {
constexpr int D = 128, NW = 8, QBLK = 32, KVBLK = 64;
constexpr float SCALE = ATT_SCALE;
constexpr float THR = 8.f;
constexpr int LDQ = ATT_IN, LDK = D, LDO = DM;
constexpr size_t SHM_V = KVBLK * D * 2, SHM_K = KVBLK * D * 2, SHM_ATTN = 2 * SHM_V + 2 * SHM_K + NW * 64 * 4;
#define KSWZ(row, colB) ((row) * 256 + ((colB) ^ (((row) & 7) << 4)))
#define SBAR() __builtin_amdgcn_sched_barrier(0)
__device__ __forceinline__ int crow(int r, int hi) { return (r & 3) + 8 * (r >> 2) + 4 * hi; }
__device__ __forceinline__ unsigned cvtpk(float lo, float hi) { unsigned r; asm volatile("v_cvt_pk_bf16_f32 %0, %1, %2" : "=v"(r) : "v"(lo), "v"(hi)); return r; }
__device__ __forceinline__ bf16x8 ld8(const bf16_t* p) { return *reinterpret_cast<const bf16x8*>(p); }

__device__ __forceinline__ void partialSM(f32x16& p0, f32x16& p1, float& m_reg, float& mn, float& alpha) {
  constexpr float C = SCALE * 1.4426950408889634f;
  float pmax = p0[0]; for (int r = 1; r < 16; ++r) pmax = fmaxf(pmax, p0[r]); for (int r = 0; r < 16; ++r) pmax = fmaxf(pmax, p1[r]);
  { auto rr = __builtin_amdgcn_permlane32_swap(__float_as_uint(pmax), __float_as_uint(pmax), false, false);
    pmax = fmaxf(__uint_as_float(rr[0]), __uint_as_float(rr[1])); }
  if (__builtin_expect(__all(pmax - m_reg <= THR / SCALE), 1)) { mn = m_reg; alpha = 1.f; }
  else { mn = fmaxf(m_reg, pmax); alpha = __builtin_amdgcn_exp2f((m_reg - mn) * C); m_reg = mn; }
  float mnC = -mn * C;
  for (int r = 0; r < 16; ++r) p0[r] = fmaf(p0[r], C, mnC); for (int r = 0; r < 16; ++r) p1[r] = fmaf(p1[r], C, mnC);
  for (int r = 0; r < 16; ++r) p0[r] = __builtin_amdgcn_exp2f(p0[r]);
}
__device__ __forceinline__ void finishSM(f32x16& p0, f32x16& p1, float alpha, float& l_reg, bf16x8& pa0, bf16x8& pa1, bf16x8& pa2, bf16x8& pa3) {
  for (int r = 0; r < 16; ++r) p1[r] = __builtin_amdgcn_exp2f(p1[r]);
  float ps = 0; for (int r = 0; r < 16; ++r) ps += p0[r]; for (int r = 0; r < 16; ++r) ps += p1[r];
  { auto rr = __builtin_amdgcn_permlane32_swap(__float_as_uint(ps), __float_as_uint(ps), false, false);
    ps = __uint_as_float(rr[0]) + __uint_as_float(rr[1]); }
  l_reg = l_reg * alpha + ps;
#define PK4(P, BASE, OUT) do { unsigned a0 = cvtpk(P[BASE + 0], P[BASE + 1]), a1 = cvtpk(P[BASE + 2], P[BASE + 3]);   \
    unsigned b0 = cvtpk(P[BASE + 4], P[BASE + 5]), b1 = cvtpk(P[BASE + 6], P[BASE + 7]);                              \
    auto r0 = __builtin_amdgcn_permlane32_swap(a0, b0, false, false); auto r1 = __builtin_amdgcn_permlane32_swap(a1, b1, false, false); \
    u32x4 w = {r0[0], r1[0], r0[1], r1[1]}; OUT = *reinterpret_cast<bf16x8*>(&w); } while (0)
  PK4(p0, 0, pa0); PK4(p0, 8, pa1); PK4(p1, 0, pa2); PK4(p1, 8, pa3);
#undef PK4
}
__device__ __forceinline__ void qkt(f32x16& p0, f32x16& p1, const bf16_t* Ks, const bf16x8* qr, int r32, int hi) {
  p0 = f32x16{}; p1 = f32x16{};
  for (int d0 = 0; d0 < 8; ++d0) { int cb = (d0 * 16 + hi * 8) * 2;
    bf16x8 b0 = *reinterpret_cast<const bf16x8*>((const char*)Ks + KSWZ(r32, cb));
    bf16x8 b1 = *reinterpret_cast<const bf16x8*>((const char*)Ks + KSWZ(32 + r32, cb));
    p0 = __builtin_amdgcn_mfma_f32_32x32x16_bf16(b0, qr[d0], p0, 0, 0, 0);
    p1 = __builtin_amdgcn_mfma_f32_32x32x16_bf16(b1, qr[d0], p1, 0, 0, 0); }
}
__device__ __forceinline__ int v_st(int k, int c) { const int kk = (k & ~0xC) | ((k & 4) << 1) | ((k & 8) >> 1); return ((kk >> 3) * 4 + (c >> 5)) * 512 + ((kk & 7) * 32 + (c & 31)) * 2; }
__device__ __forceinline__ int v_rd_base(int lane) { return ((lane & 3) << 3) | (((lane >> 2) & 3) << 6) | (((lane >> 4) & 1) << 5) | (((lane >> 5) & 1) << 8); }
constexpr int v_rd_off(int d0, int ks, int half) { return d0 * 512 + ks * 4096 + half * 2048; }
template <int OFF> __device__ __forceinline__ s16x4 tr_read(int vb) {
  s16x4 r; asm volatile("ds_read_b64_tr_b16 %0, %1 offset:%2" : "=&v"(r) : "v"(vb), "i"(OFF) : "memory"); return r;
}
template <int D0> __device__ __forceinline__ void pv_one(f32x16& od, int vb, bf16x8 pa0, bf16x8 pa1, bf16x8 pa2, bf16x8 pa3) {
  const s16x4 l0 = tr_read<v_rd_off(D0, 0, 0)>(vb), h0 = tr_read<v_rd_off(D0, 0, 1)>(vb), l1 = tr_read<v_rd_off(D0, 1, 0)>(vb), h1 = tr_read<v_rd_off(D0, 1, 1)>(vb);
  const s16x4 l2 = tr_read<v_rd_off(D0, 2, 0)>(vb), h2 = tr_read<v_rd_off(D0, 2, 1)>(vb), l3 = tr_read<v_rd_off(D0, 3, 0)>(vb), h3 = tr_read<v_rd_off(D0, 3, 1)>(vb);
  asm volatile("s_waitcnt lgkmcnt(0)" ::: "memory"); SBAR();
#define PK(L, H) (bf16x8){L[0], L[1], L[2], L[3], H[0], H[1], H[2], H[3]}
  od = __builtin_amdgcn_mfma_f32_32x32x16_bf16(pa0, PK(l0, h0), od, 0, 0, 0);
  od = __builtin_amdgcn_mfma_f32_32x32x16_bf16(pa1, PK(l1, h1), od, 0, 0, 0);
  od = __builtin_amdgcn_mfma_f32_32x32x16_bf16(pa2, PK(l2, h2), od, 0, 0, 0);
  od = __builtin_amdgcn_mfma_f32_32x32x16_bf16(pa3, PK(l3, h3), od, 0, 0, 0);
#undef PK
}
__device__ __forceinline__ void pv_d0(f32x16* o, int vb, bf16x8 pa0, bf16x8 pa1, bf16x8 pa2, bf16x8 pa3) {
  pv_one<0>(o[0], vb, pa0, pa1, pa2, pa3); pv_one<1>(o[1], vb, pa0, pa1, pa2, pa3); pv_one<2>(o[2], vb, pa0, pa1, pa2, pa3); pv_one<3>(o[3], vb, pa0, pa1, pa2, pa3);
}
__device__ __forceinline__ void attn_dense_body(const bf16_t* __restrict__ Qb, const bf16_t* __restrict__ Kh, const bf16_t* __restrict__ Vh,
                                                bf16_t* __restrict__ Ob, int seq, char* lds, const int tid) {
  const int wid = tid >> 6, lane = tid & 63, r32 = lane & 31, hi = lane >> 5;
  bf16_t* V_lds = (bf16_t*)lds; bf16_t* K_lds = (bf16_t*)(lds + 2 * SHM_V);
  float* ws = (float*)(lds + 2 * SHM_V + 2 * SHM_K) + wid * 64; float* li_l = ws; float* al_l = ws + 32;
  float m_reg = -1e30f, l_reg = 0; f32x16 o[4] = {}; bf16x8 qr[8];
  const bf16_t* Qw = Qb + (long)(wid * QBLK + r32) * LDQ + hi * 8;
#pragma unroll
  for (int d0 = 0; d0 < 8; ++d0) qr[d0] = ld8(Qw + d0 * 16);
  const int sr = tid >> 4, sc = (tid & 15) * 8, vst0 = v_st(sr, sc), vst1 = v_st(32 + sr, sc);
  const int vb0 = (int)(uintptr_t)V_lds + v_rd_base(lane);
  struct { bf16x8 vs0, vs1, ks0, ks1; } sr_[2];
#define SLOAD(i, k0) do { sr_[i].vs0 = ld8(&Vh[(long)((k0) + sr) * LDK + sc]); sr_[i].vs1 = ld8(&Vh[(long)((k0) + 32 + sr) * LDK + sc]); \
    sr_[i].ks0 = ld8(&Kh[(long)((k0) + sr) * LDK + sc]); sr_[i].ks1 = ld8(&Kh[(long)((k0) + 32 + sr) * LDK + sc]); } while (0)
#define SWRITE(b, i) do { *(bf16x8*)((char*)V_lds + (b) * SHM_V + vst0) = sr_[i].vs0;          \
    *(bf16x8*)((char*)V_lds + (b) * SHM_V + vst1) = sr_[i].vs1; int kc = sc * 2;               \
    *(bf16x8*)((char*)K_lds + (b) * SHM_K + KSWZ(sr, kc)) = sr_[i].ks0;                       \
    *(bf16x8*)((char*)K_lds + (b) * SHM_K + KSWZ(32 + sr, kc)) = sr_[i].ks1; } while (0)
#define SWAIT() asm volatile("s_waitcnt vmcnt(4)" ::: "memory")
#define RESC(a) do { if (__any((a) < 1.f)) { if (hi == 0) al_l[r32] = (a); asm volatile("s_waitcnt lgkmcnt(0)" ::: "memory"); \
    for (int d = 0; d < 4; ++d) for (int r = 0; r < 16; ++r) o[d][r] *= al_l[crow(r, hi)]; } } while (0)
  f32x16 pA0, pA1, pB0, pB1; float mnA, mnB, alA, alB; bf16x8 pa0, pa1, pa2, pa3; const int NT = seq / KVBLK;
  constexpr int SE = 0, SO = 1;
  SLOAD(SE, 0); asm volatile("s_waitcnt vmcnt(0)" ::: "memory"); SWRITE(0, SE); __syncthreads();
  qkt(pA0, pA1, K_lds, qr, r32, hi); partialSM(pA0, pA1, m_reg, mnA, alA);
  SLOAD(SO, KVBLK); if (2 < NT) SLOAD(SE, 2 * KVBLK);
  SWAIT(); SWRITE(1, SO); __syncthreads();
  for (int j = 1; j + 1 < NT; j += 2) {
    SBAR(); qkt(pB0, pB1, (bf16_t*)((char*)K_lds + SHM_K), qr, r32, hi);
    finishSM(pA0, pA1, alA, l_reg, pa0, pa1, pa2, pa3); SBAR();
    SLOAD(SO, (j + 2) * KVBLK); SBAR();
    pv_d0(o, vb0, pa0, pa1, pa2, pa3); partialSM(pB0, pB1, m_reg, mnB, alB);
    __syncthreads(); SWAIT(); SWRITE(0, SE);
    RESC(alB); __syncthreads();
    SBAR(); qkt(pA0, pA1, K_lds, qr, r32, hi);
    finishSM(pB0, pB1, alB, l_reg, pa0, pa1, pa2, pa3); SBAR();
    if (j + 3 < NT) SLOAD(SE, (j + 3) * KVBLK); SBAR();
    pv_d0(o, vb0 + (int)SHM_V, pa0, pa1, pa2, pa3); partialSM(pA0, pA1, m_reg, mnA, alA);
    __syncthreads(); SWAIT(); SWRITE(1, SO);
    RESC(alA); __syncthreads();
  }
  SBAR(); qkt(pB0, pB1, (bf16_t*)((char*)K_lds + SHM_K), qr, r32, hi);
  finishSM(pA0, pA1, alA, l_reg, pa0, pa1, pa2, pa3); SBAR();
  pv_d0(o, vb0, pa0, pa1, pa2, pa3); partialSM(pB0, pB1, m_reg, mnB, alB);
  __syncthreads(); RESC(alB);
  finishSM(pB0, pB1, alB, l_reg, pa0, pa1, pa2, pa3); SBAR();
  pv_d0(o, vb0 + (int)SHM_V, pa0, pa1, pa2, pa3);
  if (hi == 0) li_l[r32] = l_reg; asm volatile("s_waitcnt lgkmcnt(0)" ::: "memory");
  float rli[16];
#pragma unroll
  for (int r = 0; r < 16; ++r) rli[r] = __builtin_amdgcn_rcpf(li_l[crow(r, hi)]);
  bf16_t* Ow = Ob + (long)(wid * QBLK) * LDO;
#pragma unroll
  for (int r = 0; r < 16; ++r) { int orow = crow(r, hi);
#pragma unroll
    for (int d0 = 0; d0 < 4; ++d0) Ow[(long)orow * LDO + d0 * 32 + r32] = f2bf(o[d0][r] * rli[r]); }
  __syncthreads();
#undef SLOAD
#undef SWRITE
#undef SWAIT
#undef RESC
}
}

struct Ctx {
    LAS unsigned char* lds; int tid, lane, wave, G, bid;
};

__device__ __forceinline__ void transpose_job(const Ctx& F, const float* __restrict__ src, bf16_t* __restrict__ dst, int K, int N, int count) {
    LAS float* tile = (LAS float*)F.lds;
    const int tk = K / 64, tn = N / 128, per = tk * tn, total = count * per;
    const int lr = F.tid >> 5, c4 = (F.tid & 31) * 4;
    const int on = F.tid >> 2, ok = (F.tid & 3) * 16;
    f32x4 cur[4], nxt[4];
    int it = F.bid;
    if (it < total) { const int m = it / per, r = it % per, kt = r / tn, nt = r % tn; const float* s = src + (size_t)m * K * N + (size_t)(kt * 64 + lr) * N + nt * 128 + c4;
#pragma unroll
        for (int p = 0; p < 4; ++p) cur[p] = *(const f32x4*)(s + (size_t)p * 16 * N); }
    for (; it < total; it += F.G) {
        const int m = it / per, r = it % per, kt = r / tn, nt = r % tn;
        const int itn = it + F.G;
        if (itn < total) { const int m2 = itn / per, r2 = itn % per, kt2 = r2 / tn, nt2 = r2 % tn; const float* s = src + (size_t)m2 * K * N + (size_t)(kt2 * 64 + lr) * N + nt2 * 128 + c4;
#pragma unroll
            for (int p = 0; p < 4; ++p) nxt[p] = *(const f32x4*)(s + (size_t)p * 16 * N); }
#pragma unroll
        for (int p = 0; p < 4; ++p)
#pragma unroll
            for (int i = 0; i < 4; ++i) tile[(lr + 16 * p) * 129 + c4 + i] = cur[p][i];
        __syncthreads();
        float v[16];
#pragma unroll
        for (int i = 0; i < 16; ++i) v[i] = tile[(ok + i) * 129 + on];
        u32x4 w0, w1;
        w0.x = cvt_pk_bf16(v[0], v[1]); w0.y = cvt_pk_bf16(v[2], v[3]); w0.z = cvt_pk_bf16(v[4], v[5]); w0.w = cvt_pk_bf16(v[6], v[7]);
        w1.x = cvt_pk_bf16(v[8], v[9]); w1.y = cvt_pk_bf16(v[10], v[11]); w1.z = cvt_pk_bf16(v[12], v[13]); w1.w = cvt_pk_bf16(v[14], v[15]);
        bf16_t* d = dst + (size_t)m * K * N + (size_t)(nt * 128 + on) * K + kt * 64 + ok;
        *(u32x4*)d = w0; *(u32x4*)(d + 8) = w1;
        __syncthreads();
#pragma unroll
        for (int p = 0; p < 4; ++p) cur[p] = nxt[p];
    }
}

__device__ __forceinline__ void fourier_weights(const Ctx& F, const float* __restrict__ wf, bf16_t* __restrict__ fw) {
    LAS float* tab = (LAS float*)F.lds;
    if (F.tid < 256) { float s, c; sincospif((float)F.tid * (1.0f / 128.0f), &s, &c); tab[2 * F.tid] = c; tab[2 * F.tid + 1] = s; }
    __syncthreads();
    const int n = F.tid & 255, part = F.tid >> 8;
    for (int it = F.bid; it < 8 * 32; it += F.G) {
        const int ig = it >> 5, c0 = (it & 31) * 8;
        const float* w = wf + (size_t)ig * 65536 + n;
        float acc[8];
#pragma unroll
        for (int k = 0; k < 8; ++k) acc[k] = 0.f;
#pragma unroll 8
        for (int j = 0; j < 256; ++j) { const float wv = w[(size_t)j * 256];
#pragma unroll
            for (int k = 0; k < 8; ++k) acc[k] = fmaf(tab[2 * ((j * (c0 + k)) & 255) + part], wv, acc[k]); }
        const float sc = part ? -FOURIER_SCALE : FOURIER_SCALE;
        u32x4 o; o.x = cvt_pk_bf16(acc[0] * sc, acc[1] * sc); o.y = cvt_pk_bf16(acc[2] * sc, acc[3] * sc); o.z = cvt_pk_bf16(acc[4] * sc, acc[5] * sc); o.w = cvt_pk_bf16(acc[6] * sc, acc[7] * sc);
        *(u32x4*)(fw + ((size_t)(ig * 512 + part * 256 + n)) * 256 + c0) = o;
    }
    __syncthreads();
}

__device__ __forceinline__ void make_tables(const Ctx& F, float2* __restrict__ tw, float2* __restrict__ rope) {
    for (int idx = F.bid * NTHREADS + F.tid; idx < 8192 + 4096; idx += F.G * NTHREADS) {
        if (idx < 8192) { float s, c; sincospif((float)idx * (1.0f / 4096.0f), &s, &c); tw[idx] = make_float2(c, s); }
        else { const int j = idx - 8192, pos = j >> 5, i = j & 31; const float f = exp2f(-(float)i * 0.41524101186092034f); const float a = (float)pos * f;
            float s, c; sincosf(a, &s, &c); rope[j] = make_float2(c, s); }
    }
}

__device__ __forceinline__ void make_subkeys(const Ctx& F, const float* __restrict__ sk, bf16_t* __restrict__ dst) {
    for (int idx = F.bid * NTHREADS + F.tid; idx < 4 * 8 * 256 * 32; idx += F.G * NTHREADS) {
        const int kc = idx & 31, n1 = (idx >> 5) & 255, lh = idx >> 13;
        const int p = n1 >> 7, n = n1 & 127, pp = kc >> 4, d0 = (kc & 15) * 8;
        u32x4 w = {0u, 0u, 0u, 0u};
        if (p == pp) { const float* s = sk + ((size_t)(lh * 2 + p) * 128 + n) * 128 + d0; const f32x4 a = *(const f32x4*)s, b = *(const f32x4*)(s + 4);
            w.x = cvt_pk_bf16(a[0], a[1]); w.y = cvt_pk_bf16(a[2], a[3]); w.z = cvt_pk_bf16(b[0], b[1]); w.w = cvt_pk_bf16(b[2], b[3]); }
        *(u32x4*)(dst + (size_t)idx * 8) = w;
    }
}

__device__ __forceinline__ void adaln_partial(const Ctx& F, const float* __restrict__ cvec, const float* __restrict__ W, float* __restrict__ modp) {
    for (int it = F.bid; it < 8 * 3 * 32; it += F.G) {
        const int kc = it & 31, cc = (it >> 5) % 3, lj = it / 96;
        const int col = cc * 2048 + F.tid * 4;
        const float* w = W + (size_t)lj * 2048 * 6144 + (size_t)(kc * 64) * 6144 + col;
        f32x4 a0 = {0.f, 0.f, 0.f, 0.f}, a1 = {0.f, 0.f, 0.f, 0.f};
#pragma unroll 8
        for (int k = 0; k < 64; ++k) { const f32x4 wv = *(const f32x4*)(w + (size_t)k * 6144); const float c0 = cvec[kc * 64 + k], c1 = cvec[2048 + kc * 64 + k]; a0 += wv * c0; a1 += wv * c1; }
        float* o = modp + ((size_t)(lj * 32 + kc) * 2) * 6144 + col;
        *(f32x4*)o = a0; *(f32x4*)(o + 6144) = a1;
    }
}
__device__ __forceinline__ void adaln_reduce(const Ctx& F, const float* __restrict__ modp, const float* __restrict__ bias, float* __restrict__ mod) {
    for (int idx = F.bid * NTHREADS + F.tid; idx < 8 * 2 * 6144; idx += F.G * NTHREADS) {
        const int n = idx % 6144, b = (idx / 6144) & 1, lj = idx / 12288;
        float s = bias[lj * 6144 + n] + (n >= 4096 ? 1.0f : 0.0f);
        for (int kc = 0; kc < 32; ++kc) s += modp[((size_t)(lj * 32 + kc) * 2 + b) * 6144 + n];
        mod[idx] = s;
    }
}
__device__ __forceinline__ void cvt_stream(const Ctx& F, const float* __restrict__ src, bf16_t* __restrict__ dst, size_t n8) {
#pragma unroll 4
    for (size_t i = (size_t)F.bid * NTHREADS + F.tid; i < n8; i += (size_t)F.G * NTHREADS) {
        const f32x4 a = *(const f32x4*)(src + i * 8), b = *(const f32x4*)(src + i * 8 + 4);
        u32x4 w; w.x = cvt_pk_bf16(a[0], a[1]); w.y = cvt_pk_bf16(a[2], a[3]); w.z = cvt_pk_bf16(b[0], b[1]); w.w = cvt_pk_bf16(b[2], b[3]);
        *(u32x4*)(dst + i * 8) = w;
    }
}

__device__ __forceinline__ void row_load_f32(const float* __restrict__ row, int lane, float (&v)[32]) {
#pragma unroll
    for (int c = 0; c < 4; ++c) { const f32x4 a = *(const f32x4*)(row + c * 512 + lane * 8), b = *(const f32x4*)(row + c * 512 + lane * 8 + 4);
#pragma unroll
        for (int i = 0; i < 4; ++i) { v[c * 8 + i] = a[i]; v[c * 8 + 4 + i] = b[i]; } }
}
__device__ __forceinline__ void row_load_bf16(const bf16_t* __restrict__ row, int lane, float (&v)[32]) {
#pragma unroll
    for (int c = 0; c < 4; ++c) { const u32x4 w = *(const u32x4*)(row + c * 512 + lane * 8);
        v[c * 8 + 0] = bflo(w.x); v[c * 8 + 1] = bfhi(w.x); v[c * 8 + 2] = bflo(w.y); v[c * 8 + 3] = bfhi(w.y); v[c * 8 + 4] = bflo(w.z); v[c * 8 + 5] = bfhi(w.z); v[c * 8 + 6] = bflo(w.w); v[c * 8 + 7] = bfhi(w.w); }
}
__device__ __forceinline__ void row_store_f32(float* __restrict__ row, int lane, const float (&v)[32]) {
#pragma unroll
    for (int c = 0; c < 4; ++c) { f32x4 a, b;
#pragma unroll
        for (int i = 0; i < 4; ++i) { a[i] = v[c * 8 + i]; b[i] = v[c * 8 + 4 + i]; }
        *(f32x4*)(row + c * 512 + lane * 8) = a; *(f32x4*)(row + c * 512 + lane * 8 + 4) = b; }
}
__device__ __forceinline__ void row_store_bf16(bf16_t* __restrict__ row, int lane, const float (&v)[32]) {
#pragma unroll
    for (int c = 0; c < 4; ++c) { u32x4 w; w.x = cvt_pk_bf16(v[c * 8 + 0], v[c * 8 + 1]); w.y = cvt_pk_bf16(v[c * 8 + 2], v[c * 8 + 3]); w.z = cvt_pk_bf16(v[c * 8 + 4], v[c * 8 + 5]); w.w = cvt_pk_bf16(v[c * 8 + 6], v[c * 8 + 7]);
        *(u32x4*)(row + c * 512 + lane * 8) = w; }
}
__device__ __forceinline__ void row_store_i8(signed char* __restrict__ row, float* __restrict__ scale, int lane, const float (&v)[32]) {
    float m = 0.f;
#pragma unroll
    for (int i = 0; i < 32; ++i) m = fmaxf(m, fabsf(v[i]));
    m = fmaxf(wave_max(m), 1e-30f);
    const float inv = 127.0f / m;
#pragma unroll
    for (int d = 0; d < 4; ++d) { unsigned b0 = 0u, b1 = 0u;
#pragma unroll
        for (int k = 0; k < 4; ++k) { b0 = __builtin_amdgcn_cvt_pk_u8_f32(rintf(fmaf(v[d * 8 + k], inv, 128.0f)), k, b0); b1 = __builtin_amdgcn_cvt_pk_u8_f32(rintf(fmaf(v[d * 8 + 4 + k], inv, 128.0f)), k, b1); }
        *(u32x2*)(row + d * 512 + lane * 8) = (u32x2){b0 ^ 0x80808080u, b1 ^ 0x80808080u}; }
    if (lane == 0) *scale = m * (1.0f / 127.0f);
}
__device__ __forceinline__ void row_norm(float (&v)[32]) {
    float s = 0.f;
#pragma unroll
    for (int i = 0; i < 32; ++i) s += v[i];
    const float mu = wave_sum(s) * (1.0f / 2048.0f);
    float q = 0.f;
#pragma unroll
    for (int i = 0; i < 32; ++i) { v[i] -= mu; q = fmaf(v[i], v[i], q); }
    const float rstd = rsqrtf(wave_sum(q) * (1.0f / 2048.0f) + LN_EPS);
#pragma unroll
    for (int i = 0; i < 32; ++i) v[i] *= rstd;
}
__device__ __forceinline__ void row_norm_ms(float (&v)[32], float& mu_out, float& rstd_out) {
    float s = 0.f;
#pragma unroll
    for (int i = 0; i < 32; ++i) s += v[i];
    const float mu = wave_sum(s) * (1.0f / 2048.0f);
    float q = 0.f;
#pragma unroll
    for (int i = 0; i < 32; ++i) { v[i] -= mu; q = fmaf(v[i], v[i], q); }
    const float rstd = rsqrtf(wave_sum(q) * (1.0f / 2048.0f) + LN_EPS);
#pragma unroll
    for (int i = 0; i < 32; ++i) v[i] *= rstd;
    mu_out = mu; rstd_out = rstd;
}
__device__ __forceinline__ void row_modulate(float (&v)[32], const float* __restrict__ modrow, int lane) {
    float sh[32], sc[32]; row_load_f32(modrow, lane, sh); row_load_f32(modrow + 2048, lane, sc);
#pragma unroll
    for (int i = 0; i < 32; ++i) v[i] = fmaf(v[i], 1.0f + sc[i], sh[i]);
}
__device__ __forceinline__ void row_affine(float (&v)[32], const float* __restrict__ g, const float* __restrict__ b, int lane) {
    float gg[32], bb[32]; row_load_f32(g, lane, gg); row_load_f32(b, lane, bb);
#pragma unroll
    for (int i = 0; i < 32; ++i) v[i] = fmaf(v[i], gg[i], bb[i]);
}

__device__ __forceinline__ void lds_copy_vec(const Ctx& F, LAS float* dst, const float* __restrict__ src, int n) { for (int i = F.tid * 4; i < n; i += NTHREADS * 4) *(LAS f32x4*)(dst + i) = *(const f32x4*)(src + i); }
__device__ __forceinline__ void row_load_lds(const LAS float* row, int lane, float (&v)[32]) {
#pragma unroll
    for (int c = 0; c < 4; ++c) { const f32x4 a = *(const LAS f32x4*)(row + c * 512 + lane * 8), b = *(const LAS f32x4*)(row + c * 512 + lane * 8 + 4);
#pragma unroll
        for (int i = 0; i < 4; ++i) { v[c * 8 + i] = a[i]; v[c * 8 + 4 + i] = b[i]; } }
}
__device__ __forceinline__ void row_modulate_lds(float (&v)[32], const LAS float* shift, const LAS float* scale, int lane) {
    float sh[32], sc[32]; row_load_lds(shift, lane, sh); row_load_lds(scale, lane, sc);
#pragma unroll
    for (int i = 0; i < 32; ++i) v[i] = fmaf(v[i], 1.0f + sc[i], sh[i]);
}
__device__ __forceinline__ void row_affine_lds(float (&v)[32], const LAS float* g, const LAS float* b, int lane) {
    float gg[32], bb[32]; row_load_lds(g, lane, gg); row_load_lds(b, lane, bb);
#pragma unroll
    for (int i = 0; i < 32; ++i) v[i] = fmaf(v[i], gg[i], bb[i]);
}

__device__ __forceinline__ void quant_wsc_rows(const Ctx& F, const bf16_t* __restrict__ w, signed char* __restrict__ w8, float* __restrict__ wscale, int nrows) {
    for (int r = F.bid * NWAVES + F.wave; r < nrows; r += F.G * NWAVES) {
        float v[32]; row_load_bf16(w + (size_t)r * DM, F.lane, v);
        float m = 0.f;
#pragma unroll
        for (int i = 0; i < 32; ++i) m = fmaxf(m, fabsf(v[i]));
        m = fmaxf(wave_max(m), 1e-30f);
        const float inv = 127.0f / m;
#pragma unroll
        for (int d = 0; d < 4; ++d) { unsigned b0 = 0u, b1 = 0u;
#pragma unroll
            for (int k = 0; k < 4; ++k) { b0 = __builtin_amdgcn_cvt_pk_u8_f32(rintf(fmaf(v[d * 8 + k], inv, 128.0f)), k, b0); b1 = __builtin_amdgcn_cvt_pk_u8_f32(rintf(fmaf(v[d * 8 + 4 + k], inv, 128.0f)), k, b1); }
            *(u32x2*)(w8 + (size_t)r * DM + d * 512 + F.lane * 8) = (u32x2){b0 ^ 0x80808080u, b1 ^ 0x80808080u}; }
        if (F.lane == 0) wscale[r] = m * (1.0f / 127.0f);
    }
}
__device__ __forceinline__ void quant_rows_phase(const Ctx& F, const bf16_t* __restrict__ y, signed char* __restrict__ y8, float* __restrict__ ysc) {
    for (int t = F.bid * NWAVES + F.wave; t < NTOK; t += F.G * NWAVES) { float v[32]; row_load_bf16(y + (size_t)t * DM, F.lane, v); row_store_i8(y8 + (size_t)t * DM, ysc + t, F.lane, v); }
}
__device__ __forceinline__ void ln_mod_phase(const Ctx& F, const float* __restrict__ x, const float* __restrict__ modlj, signed char* __restrict__ h8i, float* __restrict__ hsc) {
    for (int t = F.bid * NWAVES + F.wave; t < NTOK; t += F.G * NWAVES) {
        float v[32]; row_load_f32(x + (size_t)t * DM, F.lane, v);
        row_norm(v); row_modulate(v, modlj + (size_t)(t / SEQ) * 6144, F.lane);
        row_store_i8(h8i + (size_t)t * DM, hsc + t, F.lane, v);
    }
}
__device__ __forceinline__ void ln2_phase(const Ctx& F, const bf16_t* __restrict__ u, const float* __restrict__ g, const float* __restrict__ b, const float* __restrict__ modlj,
                                          signed char* __restrict__ h8i  , unsigned char* __restrict__ h8, float* __restrict__ hs, float* __restrict__ lns  ) {
    LAS float* lv = (LAS float*)F.lds;
    lds_copy_vec(F, lv, g, 2048); lds_copy_vec(F, lv + 2048, b, 2048); lds_copy_vec(F, lv + 4096, modlj, 4096); lds_copy_vec(F, lv + 8192, modlj + 6144, 4096);
    __syncthreads();
    for (int t = F.bid * NWAVES + F.wave; t < NTOK; t += F.G * NWAVES) {
        float v[32]; row_load_bf16(u + (size_t)t * DM, F.lane, v);
        float mu0, rstd0; row_norm_ms(v, mu0, rstd0); row_affine_lds(v, lv, lv + 2048, F.lane);
        if (F.lane == 0) { lns[2 * t] = mu0; lns[2 * t + 1] = rstd0; }
        { const LAS float* mr = lv + 4096 + (t / SEQ) * 4096; row_norm(v); row_modulate_lds(v, mr, mr + 2048, F.lane); }
        float m = 0.f;
#pragma unroll
        for (int i = 0; i < 32; ++i) m = fmaxf(m, fabsf(v[i]));
        m = fmaxf(wave_max(m), 1e-20f);
        const float inv = 119.0f / m;
        { unsigned wh[4], wl[4];
#pragma unroll
          for (int d = 0; d < 4; ++d) { unsigned b0 = 0u, b1 = 0u;
#pragma unroll
              for (int k = 0; k < 4; ++k) { b0 = __builtin_amdgcn_cvt_pk_u8_f32(rintf(fmaf(v[d * 8 + k], inv, 136.0f)), k, b0); b1 = __builtin_amdgcn_cvt_pk_u8_f32(rintf(fmaf(v[d * 8 + 4 + k], inv, 136.0f)), k, b1); }
              { const unsigned s0_ = ((b0 & 0x7F7F7F7Fu) + 0x78787878u) ^ ((b0 ^ 0x78787878u) & 0x80808080u), s1_ = ((b1 & 0x7F7F7F7Fu) + 0x78787878u) ^ ((b1 ^ 0x78787878u) & 0x80808080u);
                *(u32x2*)(h8i + (size_t)t * DM + d * 512 + F.lane * 8) = (u32x2){s0_, s1_}; }
              b0 ^= 0x88888888u; b1 ^= 0x88888888u;
              wh[d] = (b0 & 0xF0F0F0F0u) | ((b1 >> 4) & 0x0F0F0F0Fu);
              wl[d] = ((b0 << 4) & 0xF0F0F0F0u) | (b1 & 0x0F0F0F0Fu); }
          *(u32x4*)(h8 + (size_t)t * DM + F.lane * 16) = (u32x4){wh[0], wh[1], wh[2], wh[3]};
          *(u32x4*)(h8 + (size_t)t * DM + 1024 + F.lane * 16) = (u32x4){wl[0], wl[1], wl[2], wl[3]}; }
        if (F.lane == 0) hs[t] = m * (1.0f / 119.0f);
    }
    __syncthreads();
}

template <bool SGN  >
__device__ __forceinline__ void quant4_rows(const Ctx& F, const float* __restrict__ src, unsigned char* __restrict__ dst, bf16_t* __restrict__ scl, int nrows) {
    float v[32], nx[32];
    int r = F.bid * NWAVES + F.wave;
    if (r < nrows) row_load_f32(src + (size_t)r * DM, F.lane, v);
    for (; r < nrows; r += F.G * NWAVES) {
        const int rn = r + F.G * NWAVES;
        if (rn < nrows) row_load_f32(src + (size_t)rn * DM, F.lane, nx);
        float m = 0.f;
#pragma unroll
        for (int i = 0; i < 32; ++i) m = fmaxf(m, fabsf(v[i]));
        m = fmaxf(m, DPPF(m, 0xB1));
        const bf16_t sb = f2bf(fmaxf(m, 1e-30f) * (1.0f / 7.0f));
        const float inv = 1.0f / bf2f(sb);
        unsigned w[4];
#pragma unroll
        for (int d = 0; d < 4; ++d) { unsigned x = 0u;
#pragma unroll
            for (int k = 0; k < 8; ++k) { int q = (int)rintf(v[d * 8 + k] * inv); q = min(max(q, -7), 7);
                if (SGN) x |= ((unsigned)q & 15u) << ((k < 4) ? 8 * k + 4 : 8 * (k - 4)); else x |= (unsigned)(q + 8) << (4 * k); }
            w[d] = x; }
        const size_t srow = ((size_t)((r >> 14) * 8 + (F.lane >> 3)) * NEXP + (r & (NEXP - 1)));
        *(u32x4*)(dst + srow * 128 + (F.lane & 7) * 16) = (u32x4){w[0], w[1], w[2], w[3]};
        if ((F.lane & 1) == 0) scl[srow * 4 + ((F.lane & 7) >> 1)] = sb;
#pragma unroll
        for (int i = 0; i < 32; ++i) v[i] = nx[i];
    }
}

__device__ __forceinline__ void quant_fp4_rows(const Ctx& F, const float* __restrict__ src, unsigned char* __restrict__ dst, bf16_t* __restrict__ scl, int nrows) {
    f32x4 v[8], nx[8];
    int r = F.bid * NWAVES + F.wave;
    if (r < nrows) {
#pragma unroll
        for (int i = 0; i < 8; ++i) v[i] = *(const f32x4*)(src + (size_t)r * DM + F.lane * 32 + i * 4); }
    for (; r < nrows; r += F.G * NWAVES) {
        const int rn = r + F.G * NWAVES;
        if (rn < nrows) {
#pragma unroll
            for (int i = 0; i < 8; ++i) nx[i] = *(const f32x4*)(src + (size_t)rn * DM + F.lane * 32 + i * 4); }
        float m = 0.f;
#pragma unroll
        for (int i = 0; i < 8; ++i) m = fmaxf(fmaxf(m, fmaxf(fabsf(v[i][0]), fabsf(v[i][1]))), fmaxf(fabsf(v[i][2]), fabsf(v[i][3])));
        m = fmaxf(m, DPPF(m, 0xB1)); m = fmaxf(m, DPPF(m, 0x4E)); m = fmaxf(m, DPPF(m, 0x141));
        const bf16_t sb = f2bf(fmaxf(m, 1e-30f) * (1.0f / 6.0f));
        const float inv = 1.0f / bf2f(sb);
        unsigned hw[8];
#pragma unroll
        for (int j = 0; j < 8; ++j) hw[j] = 0u;
#pragma unroll
        for (int qq = 0; qq < 32; ++qq) {
            const float y = v[qq >> 2][qq & 3] * inv; const float a = fminf(fabsf(y), 6.0f);
            const float f = a < 2.0f ? 2.0f : (a < 4.0f ? 1.0f : 0.5f); const int off = a < 2.0f ? 0 : (a < 4.0f ? 2 : 4);
            const unsigned code = (unsigned)((int)rintf(a * f) + off) | (y < 0.f ? 8u : 0u);
            hw[((qq >> 2) & 1) * 4 + (qq & 3)] |= code << (4 * (qq >> 3)); }
        const int L = r >> 14, e = r & (NEXP - 1), xs = F.lane >> 3, kq = (F.lane >> 1) & 3, odd = F.lane & 1;
        const size_t srow = (size_t)(L * 8 + xs) * NEXP + e;
        unsigned* row = (unsigned*)(dst + srow * 128);
#pragma unroll
        for (int rr = 0; rr < 4; ++rr) {
            const unsigned mine = odd ? hw[4 + rr] : hw[rr], other = odd ? hw[rr] : hw[4 + rr];
            const unsigned got = (unsigned)__builtin_amdgcn_update_dpp(0, (int)other, 0xB1, 0xF, 0xF, true);
            row[(4 * kq + rr) * 2 + odd] = odd ? (got | (mine << 16)) : (mine | (got << 16)); }
        if ((F.lane & 7) == 0) scl[((size_t)L * NEXP + e) * 8 + xs] = sb;
#pragma unroll
        for (int i = 0; i < 8; ++i) v[i] = nx[i];
    }
}

__device__ __forceinline__ void pool_phase(const Ctx& F, const bf16_t* __restrict__ zb, bf16_t* __restrict__ pb) {
    const int ch = F.tid & 127, tq = F.tid >> 7, g = ch >> 5, half = 1 << g;
    __syncthreads();
    for (int it = F.bid; it < NTOK / 32; it += F.G) {
        const int t0 = it * 32, s0 = t0 & (SEQ - 1), tb = t0 - s0, rbase = s0 - 8;
#pragma unroll
        for (int k = 0; k < 12; ++k) { const int id = k * NTHREADS + F.tid, row = id >> 7, c16 = id & 127, s = rbase + row;
            if (s >= 0 && s < SEQ) *(LAS u32x4*)(F.lds + row * 2048 + c16 * 16) = *(const u32x4*)(zb + (size_t)(tb + s) * DM + 1024 + c16 * 8); }
        __syncthreads();
        const LAS unsigned char* col = F.lds + ch * 16;
#define POOL_ROW(r) (*(const LAS u32x4*)(col + ((r) - rbase) * 2048))
#define POOL_ACC(V_, sgn) do { acc[0] += sgn bflo(V_.x); acc[1] += sgn bfhi(V_.x); acc[2] += sgn bflo(V_.y); acc[3] += sgn bfhi(V_.y); acc[4] += sgn bflo(V_.z); acc[5] += sgn bfhi(V_.z); acc[6] += sgn bflo(V_.w); acc[7] += sgn bfhi(V_.w); } while (0)
        const int sa = s0 + tq * 8;
        float acc[8];
#pragma unroll
        for (int i = 0; i < 8; ++i) acc[i] = 0.f;
        for (int r = max(sa - half, 0); r < min(sa + half, SEQ); ++r) { const u32x4 w = POOL_ROW(r); POOL_ACC(w, +); }
#pragma unroll
        for (int k = 0; k < 8; ++k) {
            const int s = sa + k, lo = max(s - half, 0), hi = min(s + half, SEQ);
            const u32x4 zc = POOL_ROW(s);
            const float inv = 1.0f / (float)(hi - lo);
            float o[8];
            o[0] = acc[0] * inv - bflo(zc.x); o[1] = acc[1] * inv - bfhi(zc.x); o[2] = acc[2] * inv - bflo(zc.y); o[3] = acc[3] * inv - bfhi(zc.y);
            o[4] = acc[4] * inv - bflo(zc.z); o[5] = acc[5] * inv - bfhi(zc.z); o[6] = acc[6] * inv - bflo(zc.w); o[7] = acc[7] * inv - bfhi(zc.w);
            u32x4 w; w.x = cvt_pk_bf16(o[0], o[1]); w.y = cvt_pk_bf16(o[2], o[3]); w.z = cvt_pk_bf16(o[4], o[5]); w.w = cvt_pk_bf16(o[6], o[7]);
            *(u32x4*)(pb + (size_t)(tb + s) * 1024 + ch * 8) = w;
            if (s + half < SEQ) { const u32x4 wn = POOL_ROW(s + half); POOL_ACC(wn, +); }
            if (s - half >= 0) { const u32x4 wo = POOL_ROW(s - half); POOL_ACC(wo, -); }
        }
#undef POOL_ROW
#undef POOL_ACC
        __syncthreads();
    }
}
__device__ __forceinline__ int crow32(int r, int hi) { return (r & 3) + 8 * (r >> 2) + 4 * hi; }

template <int OFF> __device__ __forceinline__ s16x4 dft_tr(int addr) { s16x4 r; asm volatile("ds_read_b64_tr_b16 %0, %1 offset:%2" : "=&v"(r) : "v"(addr), "i"(OFF) : "memory"); return r; }
__device__ __forceinline__ void dft1_phase(const Ctx& F, const bf16_t* __restrict__ pq, const float2* __restrict__ tw, bf16_t* __restrict__ yr, bf16_t* __restrict__ yi) {
    LAS unsigned char* tab = F.lds;
    for (int e = F.tid; e < 4 * 8 * 64; e += NTHREADS) {
        const int ln = e & 63, ks = (e >> 6) & 7, mb = e >> 9, m = mb * 32 + (ln & 31), po = m >> 6, k1 = m & 63;
        float v[8];
#pragma unroll
        for (int j = 0; j < 8; ++j) { const int k = ks * 16 + 8 * (ln >> 5) + j, pi = k >> 6, s1 = k & 63; float s, c; sincospif((float)((k1 * s1) & 63) * (1.0f / 32.0f), &s, &c);
            v[j] = (po == pi) ? c : (po == 0 ? s : -s); }
        u32x4 w; w.x = cvt_pk_bf16(v[0], v[1]); w.y = cvt_pk_bf16(v[2], v[3]); w.z = cvt_pk_bf16(v[4], v[5]); w.w = cvt_pk_bf16(v[6], v[7]);
        *(LAS u32x4*)(tab + (size_t)e * 16) = w;
    }
    __syncthreads();
    LAS unsigned char* tile = F.lds + 32768 + F.wave * 8192;
    const int l31 = F.lane & 31, hh = F.lane >> 5, i16 = F.lane & 15, g1 = (F.lane >> 4) & 1;
    const int trb = (int)(uintptr_t)tile + (8 * hh + (i16 >> 2)) * 64 + g1 * 32 + (i16 & 3) * 8;
    for (int it = F.bid * NWAVES + F.wave; it < 2 * 128 * 32; it += F.G * NWAVES) {
        const int nb = it & 31, s2 = (it >> 5) & 127, b = it >> 12;
        const int n0 = nb * 32, g = n0 >> 8, d0 = n0 & 255;
        u32x4 v[8];
#pragma unroll
        for (int i = 0; i < 8; ++i) { const int c = F.lane + 64 * i, k = c >> 2, seg = c & 3;
            v[i] = *(const u32x4*)(pq + ((size_t)b * SEQ + 128 * (k & 63) + s2) * DM + g * 512 + (k >> 6) * 256 + d0 + seg * 8); }
        asm volatile("s_waitcnt lgkmcnt(0)" ::: "memory");
#pragma unroll
        for (int i = 0; i < 8; ++i) { const int c = F.lane + 64 * i; *(LAS u32x4*)(tile + (c >> 2) * 64 + (c & 3) * 16) = v[i]; }
        asm volatile("s_waitcnt lgkmcnt(0)" ::: "memory");
        f32x16 acc[4] = {};
        { s16x4 blo[8], bhi[8];
          blo[0] = dft_tr<0 * 1024>(trb); bhi[0] = dft_tr<0 * 1024 + 256>(trb); blo[1] = dft_tr<1 * 1024>(trb); bhi[1] = dft_tr<1 * 1024 + 256>(trb);
          blo[2] = dft_tr<2 * 1024>(trb); bhi[2] = dft_tr<2 * 1024 + 256>(trb); blo[3] = dft_tr<3 * 1024>(trb); bhi[3] = dft_tr<3 * 1024 + 256>(trb);
          blo[4] = dft_tr<4 * 1024>(trb); bhi[4] = dft_tr<4 * 1024 + 256>(trb); blo[5] = dft_tr<5 * 1024>(trb); bhi[5] = dft_tr<5 * 1024 + 256>(trb);
          blo[6] = dft_tr<6 * 1024>(trb); bhi[6] = dft_tr<6 * 1024 + 256>(trb); blo[7] = dft_tr<7 * 1024>(trb); bhi[7] = dft_tr<7 * 1024 + 256>(trb);
          asm volatile("s_waitcnt lgkmcnt(0)" ::: "memory"); __builtin_amdgcn_sched_barrier(0);
#pragma unroll
          for (int ks = 0; ks < 8; ++ks) {
              const bf16x8 bfr = {blo[ks][0], blo[ks][1], blo[ks][2], blo[ks][3], bhi[ks][0], bhi[ks][1], bhi[ks][2], bhi[ks][3]};
#pragma unroll
              for (int mb = 0; mb < 4; ++mb) { const bf16x8 af = *(const LAS bf16x8*)(tab + ((size_t)((mb * 8 + ks) * 64 + F.lane)) * 16);
                  acc[mb] = __builtin_amdgcn_mfma_f32_32x32x16_bf16(af, bfr, acc[mb], 0, 0, 0); }
          }
          __builtin_amdgcn_sched_barrier(0); }
        const int n = n0 + l31;
#pragma unroll
        for (int kb = 0; kb < 2; ++kb)
#pragma unroll
            for (int r = 0; r < 16; ++r) {
                const int k1 = kb * 32 + crow32(r, hh);
                const float2 t = tw[k1 * s2];
                const float a = acc[kb][r], bb = acc[2 + kb][r];
                const size_t o = (((size_t)b * 64 + k1) * 128 + s2) * 1024 + n;
                yr[o] = f2bf(a * t.x + bb * t.y); yi[o] = f2bf(bb * t.x - a * t.y);
            }
    }
    __syncthreads();
}
__device__ __forceinline__ void dft2_phase(const Ctx& F, const bf16_t* __restrict__ yr, const bf16_t* __restrict__ yi, bf16_t* __restrict__ ymix) {
    LAS unsigned char* tab = F.lds;
    for (int e = F.tid; e < 4 * 16 * 64; e += NTHREADS) {
        const int ln = e & 63, ks = (e >> 6) & 15, mb = e >> 10, k2 = mb * 32 + (ln & 31);
        float v[8];
#pragma unroll
        for (int j = 0; j < 8; ++j) { const int k = ks * 16 + 8 * (ln >> 5) + j, part = k >> 7, s2 = k & 127; float s, c; sincospif((float)((k2 * s2) & 127) * (1.0f / 64.0f), &s, &c);
            v[j] = part ? s : c; }
        u32x4 w; w.x = cvt_pk_bf16(v[0], v[1]); w.y = cvt_pk_bf16(v[2], v[3]); w.z = cvt_pk_bf16(v[4], v[5]); w.w = cvt_pk_bf16(v[6], v[7]);
        *(LAS u32x4*)(tab + (size_t)e * 16) = w;
    }
    __syncthreads();
    LAS unsigned char* tile = F.lds + 65536 + F.wave * 8192;
    const int l31 = F.lane & 31, hh = F.lane >> 5, i16 = F.lane & 15, g1 = (F.lane >> 4) & 1;
    const int trb = (int)(uintptr_t)tile + (8 * hh + (i16 >> 2)) * 64 + g1 * 32 + (i16 & 3) * 8;
    for (int it = F.bid * NWAVES + F.wave; it < 2 * 64 * 32; it += F.G * NWAVES) {
        const int nb = it & 31, k1 = (it >> 5) & 63, b = it >> 11;
        const int n0 = nb * 32;
        f32x16 acc[4] = {};
#pragma unroll
        for (int plane = 0; plane < 2; ++plane) {
            const bf16_t* src = (plane ? yi : yr) + (((size_t)b * 64 + k1) * 128) * 1024 + n0;
            u32x4 v[8];
#pragma unroll
            for (int i = 0; i < 8; ++i) { const int c = F.lane + 64 * i; v[i] = *(const u32x4*)(src + (size_t)(c >> 2) * 1024 + (c & 3) * 8); }
            asm volatile("s_waitcnt lgkmcnt(0)" ::: "memory");
#pragma unroll
            for (int i = 0; i < 8; ++i) { const int c = F.lane + 64 * i; *(LAS u32x4*)(tile + (c >> 2) * 64 + (c & 3) * 16) = v[i]; }
            asm volatile("s_waitcnt lgkmcnt(0)" ::: "memory");
            s16x4 blo[8], bhi[8];
            blo[0] = dft_tr<0 * 1024>(trb); bhi[0] = dft_tr<0 * 1024 + 256>(trb); blo[1] = dft_tr<1 * 1024>(trb); bhi[1] = dft_tr<1 * 1024 + 256>(trb);
            blo[2] = dft_tr<2 * 1024>(trb); bhi[2] = dft_tr<2 * 1024 + 256>(trb); blo[3] = dft_tr<3 * 1024>(trb); bhi[3] = dft_tr<3 * 1024 + 256>(trb);
            blo[4] = dft_tr<4 * 1024>(trb); bhi[4] = dft_tr<4 * 1024 + 256>(trb); blo[5] = dft_tr<5 * 1024>(trb); bhi[5] = dft_tr<5 * 1024 + 256>(trb);
            blo[6] = dft_tr<6 * 1024>(trb); bhi[6] = dft_tr<6 * 1024 + 256>(trb); blo[7] = dft_tr<7 * 1024>(trb); bhi[7] = dft_tr<7 * 1024 + 256>(trb);
            asm volatile("s_waitcnt lgkmcnt(0)" ::: "memory"); __builtin_amdgcn_sched_barrier(0);
#pragma unroll
            for (int ks = 0; ks < 8; ++ks) {
                const bf16x8 bfr = {blo[ks][0], blo[ks][1], blo[ks][2], blo[ks][3], bhi[ks][0], bhi[ks][1], bhi[ks][2], bhi[ks][3]};
#pragma unroll
                for (int mb = 0; mb < 4; ++mb) { const bf16x8 af = *(const LAS bf16x8*)(tab + ((size_t)((mb * 16 + plane * 8 + ks) * 64 + F.lane)) * 16);
                    acc[mb] = __builtin_amdgcn_mfma_f32_32x32x16_bf16(af, bfr, acc[mb], 0, 0, 0); }
            }
            __builtin_amdgcn_sched_barrier(0);
        }
        const int n = n0 + l31;
#pragma unroll
        for (int mb = 0; mb < 4; ++mb)
#pragma unroll
            for (int r = 0; r < 16; ++r) { const int k2 = mb * 32 + crow32(r, hh); const size_t t = (size_t)b * SEQ + k1 + 64 * k2;
                ymix[t * DM + n] = f2bf(acc[mb][r]); }
    }
    __syncthreads();
}


__device__ __forceinline__ void qk_norm_rope_phase(const Ctx& F, bf16_t* __restrict__ proj, const float* __restrict__ qn, const float* __restrict__ kn, const float2* __restrict__ rope,
                                                   bf16_t* __restrict__ kc, bf16_t* __restrict__ vc) {
    const int a = F.lane >> 5, i = F.lane & 31, off = 64 * a + i;
    const float gq1 = qn[off], gq2 = qn[off + 32], gk1 = kn[off], gk2 = kn[off + 32];
    for (int t = F.bid * NWAVES + F.wave; t < NTOK; t += F.G * NWAVES) {
        const int s = t & (SEQ - 1), b = t / SEQ;
        bf16_t* p = proj + (size_t)t * ATT_IN + off;
        bf16_t r1[12], r2[12];
#pragma unroll
        for (int sl = 0; sl < 12; ++sl) { r1[sl] = p[sl * 128]; r2[sl] = p[sl * 128 + 32]; }
        const int pos = a ? (s & 63) : (s >> 6);
        const float2 cs = rope[pos * 32 + i];
#pragma unroll
        for (int sl = 0; sl < 10; ++sl) {
            float x1 = bf2f(r1[sl]), x2 = bf2f(r2[sl]);
            const float ss = wave_sum(x1 * x1 + x2 * x2) * (1.0f / 128.0f);
            const float r = rsqrtf(ss + LN_EPS);
            x1 = x1 * r * (sl < 8 ? gq1 : gk1); x2 = x2 * r * (sl < 8 ? gq2 : gk2);
            bf16_t* o = (sl < 8) ? p + sl * 128 : kc + ((size_t)(b * 2 + (sl - 8)) * SEQ + s) * 128 + off;
            o[0] = f2bf(x1 * cs.x - x2 * cs.y); o[32] = f2bf(x2 * cs.x + x1 * cs.y);
        }
#pragma unroll
        for (int sl = 10; sl < 12; ++sl) { bf16_t* o = vc + ((size_t)(b * 2 + (sl - 10)) * SEQ + s) * 128 + off; o[0] = r1[sl]; o[32] = r2[sl]; }
    }
}

__device__ __forceinline__ void natten_phase(const Ctx& F, const bf16_t* __restrict__ proj, const float* __restrict__ rpb, bf16_t* __restrict__ ymix) {
    LAS float* wl = (LAS float*)(F.lds + F.wave * 1024);
    LAS unsigned* ql = (LAS unsigned*)wl; LAS float* pl = wl + 64;
    for (int it = F.bid * NWAVES + F.wave; it < NTOK * 8; it += F.G * NWAVES) {
        const int hh = it & 7, t = it >> 3, s = t & (SEQ - 1), r = s >> 6, j = s & 63;
        const int rs = min(max(r - 4, 0), 120), cs = min(max(j - 8, 0), 48);
        const bf16_t* qp = proj + (size_t)t * ATT_IN + 1536 + hh * 128;
        const bf16_t* kbase = proj + (size_t)(t - s) * ATT_IN + 2560 + hh * 128;
        const bf16_t* vbase = proj + (size_t)(t - s) * ATT_IN + 3584 + hh * 128;
        ql[F.lane] = *(const unsigned*)(qp + 2 * F.lane);
        asm volatile("s_waitcnt lgkmcnt(0)" ::: "memory");
        float sc2[2];
#pragma unroll
        for (int kk2 = 0; kk2 < 2; ++kk2) {
            const int kk = F.lane + 64 * kk2, i = kk >> 4, w = kk & 15;
            const bf16_t* kr = kbase + (size_t)((rs + i) * 64 + cs + w) * ATT_IN;
            float acc = 0.f;
#pragma unroll
            for (int d8 = 0; d8 < 16; ++d8) { const u32x4 kv = *(const u32x4*)(kr + d8 * 8); const u32x4 qv = *(const LAS u32x4*)(ql + d8 * 4);
                acc = fmaf(bflo(kv.x), bflo(qv.x), acc); acc = fmaf(bfhi(kv.x), bfhi(qv.x), acc); acc = fmaf(bflo(kv.y), bflo(qv.y), acc); acc = fmaf(bfhi(kv.y), bfhi(qv.y), acc);
                acc = fmaf(bflo(kv.z), bflo(qv.z), acc); acc = fmaf(bfhi(kv.z), bfhi(qv.z), acc); acc = fmaf(bflo(kv.w), bflo(qv.w), acc); acc = fmaf(bfhi(kv.w), bfhi(qv.w), acc); }
            const int ro = rs + i - r + 7, co = cs + w - j + 15;
            sc2[kk2] = acc * ATT_SCALE + rpb[(hh * 15 + ro) * 31 + co];
        }
        const float mx = wave_max(fmaxf(sc2[0], sc2[1]));
        const float e0 = __expf(sc2[0] - mx), e1 = __expf(sc2[1] - mx);
        const float inv = 1.0f / wave_sum(e0 + e1);
        pl[F.lane] = e0 * inv; pl[F.lane + 64] = e1 * inv;
        asm volatile("s_waitcnt lgkmcnt(0)" ::: "memory");
        float o0 = 0.f, o1 = 0.f;
#pragma unroll 8
        for (int kk = 0; kk < 128; ++kk) { const int i = kk >> 4, w = kk & 15;
            const unsigned vv = *(const unsigned*)(vbase + (size_t)((rs + i) * 64 + cs + w) * ATT_IN + 2 * F.lane); const float pw = pl[kk];
            o0 = fmaf(pw, bflo(vv), o0); o1 = fmaf(pw, bfhi(vv), o1); }
        *(unsigned*)(ymix + (size_t)t * DM + 1024 + hh * 128 + 2 * F.lane) = cvt_pk_bf16(o0, o1);
    }
    __syncthreads();
}

__device__ __forceinline__ float xlane_f(float v, int srclane) { return __int_as_float(__builtin_amdgcn_ds_bpermute(srclane << 2, __float_as_int(v))); }
template <int OFF> __device__ __forceinline__ s16x4 tr_read_b64(int addr) {
    s16x4 r; asm volatile("ds_read_b64_tr_b16 %0, %1 offset:%2" : "=&v"(r) : "v"(addr), "i"(OFF) : "memory"); return r;
}
__device__ __forceinline__ void natten_pv_row(f32x4 (&o)[8], int trb, bf16x8 pb) {
    s16x4 lo[8], hi[8];
    lo[0] = tr_read_b64<0 * 32>(trb); hi[0] = tr_read_b64<0 * 32 + 16 * 288>(trb); lo[1] = tr_read_b64<1 * 32>(trb); hi[1] = tr_read_b64<1 * 32 + 16 * 288>(trb);
    lo[2] = tr_read_b64<2 * 32>(trb); hi[2] = tr_read_b64<2 * 32 + 16 * 288>(trb); lo[3] = tr_read_b64<3 * 32>(trb); hi[3] = tr_read_b64<3 * 32 + 16 * 288>(trb);
    lo[4] = tr_read_b64<4 * 32>(trb); hi[4] = tr_read_b64<4 * 32 + 16 * 288>(trb); lo[5] = tr_read_b64<5 * 32>(trb); hi[5] = tr_read_b64<5 * 32 + 16 * 288>(trb);
    lo[6] = tr_read_b64<6 * 32>(trb); hi[6] = tr_read_b64<6 * 32 + 16 * 288>(trb); lo[7] = tr_read_b64<7 * 32>(trb); hi[7] = tr_read_b64<7 * 32 + 16 * 288>(trb);
    asm volatile("s_waitcnt lgkmcnt(0)" ::: "memory"); __builtin_amdgcn_sched_barrier(0);
#pragma unroll
    for (int mt = 0; mt < 8; ++mt) { const bf16x8 a = {lo[mt][0], lo[mt][1], lo[mt][2], lo[mt][3], hi[mt][0], hi[mt][1], hi[mt][2], hi[mt][3]};
        o[mt] = __builtin_amdgcn_mfma_f32_16x16x32_bf16(a, pb, o[mt], 0, 0, 0); }
    __builtin_amdgcn_sched_barrier(0);
}
__device__ __forceinline__ void natten_mfma_phase(const Ctx& F, const bf16_t* __restrict__ proj, const float* __restrict__ rpb, bf16_t* __restrict__ ymix) {
    LAS float* bl = (LAS float*)(F.lds + 8 * 9216);
    for (int i = F.tid; i < 8 * 15 * 31; i += NTHREADS) bl[i] = rpb[i];
    __syncthreads();
    LAS unsigned char* vt = F.lds + F.wave * 9216;
    const int n16 = F.lane & 15, g = F.lane >> 4;
    const int trb = (int)(uintptr_t)vt + (4 * g + (n16 >> 2)) * 288 + (n16 & 3) * 8;
    for (int it = F.bid * NWAVES + F.wave; it < 2 * 8 * 128 * 4; it += F.G * NWAVES) {
        const int qb = it & 3, r = (it >> 2) & 127, hh = (it >> 9) & 7, b = it >> 12;
        const int rs = min(max(r - 4, 0), 120), j0 = qb * 16, c0 = min(max(j0 - 8, 0), 32);
        const size_t tb = (size_t)b * SEQ;
        const int j = j0 + n16, cs = min(max(j - 8, 0), 48);
        const bf16_t* qrow = proj + (tb + r * 64 + j) * ATT_IN + 1536 + hh * 128 + 8 * g;
        bf16x8 qf[4];
#pragma unroll
        for (int ks = 0; ks < 4; ++ks) qf[ks] = *(const bf16x8*)(qrow + 32 * ks);
        float sc[8][2][4];
        float mx = -1e30f;
#pragma unroll
        for (int i = 0; i < 8; ++i)
#pragma unroll
            for (int kt = 0; kt < 2; ++kt) {
                const bf16_t* krow = proj + (tb + (rs + i) * 64 + c0 + 16 * kt + n16) * ATT_IN + 2560 + hh * 128 + 8 * g;
                f32x4 a = {0.f, 0.f, 0.f, 0.f};
#pragma unroll
                for (int ks = 0; ks < 4; ++ks) a = __builtin_amdgcn_mfma_f32_16x16x32_bf16(*(const bf16x8*)(krow + 32 * ks), qf[ks], a, 0, 0, 0);
                const LAS float* brow = bl + (hh * 15 + (rs + i - r + 7)) * 31;
#pragma unroll
                for (int q = 0; q < 4; ++q) { const int kc = c0 + 16 * kt + 4 * g + q; const bool ok = (kc >= cs) && (kc < cs + 16);
                    const float bias = brow[ok ? (kc - j + 15) : 0];
                    const float s = ok ? fmaf(a[q], ATT_SCALE, bias) : -1e30f;
                    sc[i][kt][q] = s; mx = fmaxf(mx, s); }
            }
        mx = fmaxf(mx, xlane_f(mx, F.lane ^ 16)); mx = fmaxf(mx, xlane_f(mx, F.lane ^ 32));
        float sum = 0.f;
#pragma unroll
        for (int i = 0; i < 8; ++i)
#pragma unroll
            for (int kt = 0; kt < 2; ++kt)
#pragma unroll
                for (int q = 0; q < 4; ++q) { const float e = __expf(sc[i][kt][q] - mx); sc[i][kt][q] = e; sum += e; }
        sum += xlane_f(sum, F.lane ^ 16); sum += xlane_f(sum, F.lane ^ 32);
        const float inv = 1.0f / sum;
        f32x4 o[8];
#pragma unroll
        for (int mt = 0; mt < 8; ++mt) o[mt] = (f32x4){0.f, 0.f, 0.f, 0.f};
#pragma unroll
        for (int i = 0; i < 8; ++i) {
            u32x4 vv[8];
#pragma unroll
            for (int c = 0; c < 8; ++c) { const int id = F.lane + 64 * c, row = id >> 4, col16 = id & 15;
                vv[c] = *(const u32x4*)(proj + (tb + (rs + i) * 64 + c0 + row) * ATT_IN + 3584 + hh * 128 + col16 * 8); }
            asm volatile("s_waitcnt lgkmcnt(0)" ::: "memory");
#pragma unroll
            for (int c = 0; c < 8; ++c) { const int id = F.lane + 64 * c, row = id >> 4, col16 = id & 15;
                *(LAS u32x4*)(vt + row * 288 + col16 * 16) = vv[c]; }
            asm volatile("s_waitcnt lgkmcnt(0)" ::: "memory");
            u32x4 w; w.x = cvt_pk_bf16(sc[i][0][0], sc[i][0][1]); w.y = cvt_pk_bf16(sc[i][0][2], sc[i][0][3]); w.z = cvt_pk_bf16(sc[i][1][0], sc[i][1][1]); w.w = cvt_pk_bf16(sc[i][1][2], sc[i][1][3]);
            const bf16x8 pb = *reinterpret_cast<bf16x8*>(&w);
            natten_pv_row(o, trb, pb);
        }
        bf16_t* orow = ymix + (tb + r * 64 + j) * DM + 1024 + hh * 128 + 4 * g;
#pragma unroll
        for (int mt = 0; mt < 8; ++mt) { u32x2 w; w.x = cvt_pk_bf16(o[mt][0] * inv, o[mt][1] * inv); w.y = cvt_pk_bf16(o[mt][2] * inv, o[mt][3] * inv);
            *(u32x2*)(orow + 16 * mt) = w; }
    }
    __syncthreads();
}

__device__ __forceinline__ unsigned sortable(float f) { const unsigned u = __float_as_uint(f); return (u & 0x80000000u) ? ~u : (u | 0x80000000u); }
__device__ __forceinline__ float unsortable(unsigned k) { return __uint_as_float((k & 0x80000000u) ? (k ^ 0x80000000u) : ~k); }
#define INS16(L, key) do { unsigned _k = (key); _Pragma("unroll") for (int _m = 0; _m < 16; ++_m) { const unsigned _h = max(L[_m], _k); _k = min(L[_m], _k); L[_m] = _h; } } while (0)
__device__ __forceinline__ void sort16_desc(unsigned (&a)[16]) {
#pragma unroll
    for (int k = 2; k <= 16; k <<= 1)
#pragma unroll
        for (int j = k >> 1; j >= 1; j >>= 1)
#pragma unroll
            for (int i = 0; i < 16; ++i) { const int l = i ^ j; if (l > i) { const unsigned hi = max(a[i], a[l]), lo = min(a[i], a[l]); if ((i & k) == 0) { a[i] = hi; a[l] = lo; } else { a[i] = lo; a[l] = hi; } } }
}
__device__ __forceinline__ void merge_top16(unsigned (&R)[16], const unsigned (&C)[16]) {
#pragma unroll
    for (int i = 0; i < 16; ++i) R[i] = max(R[i], C[15 - i]);
#pragma unroll
    for (int j = 8; j >= 1; j >>= 1)
#pragma unroll
        for (int i = 0; i < 16; ++i) { const int l = i ^ j; if (l > i) { const unsigned hi = max(R[i], R[l]), lo = min(R[i], R[l]); R[i] = hi; R[l] = lo; } }
}
__device__ __forceinline__ void topk_phase(const Ctx& F, const bf16_t* __restrict__ sc, int* __restrict__ eidx, float* __restrict__ eg) {
    constexpr int RS = 80;
    for (int blk = F.bid; blk < NTOK / 64; blk += F.G) {
        const bf16_t* slab = sc + (size_t)blk * 64 * DM;
        unsigned L1[16], L2[16], Fk[16];
#pragma unroll
        for (int m = 0; m < 16; ++m) { L1[m] = 0u; L2[m] = 0u; Fk[m] = 0u; }
        u32x4 pre[4];
#pragma unroll
        for (int q = 0; q < 4; ++q) { const int idx = q * NTHREADS + F.tid; pre[q] = *(const u32x4*)(slab + (size_t)(idx >> 2) * 256 + (idx & 3) * 8); }
#pragma unroll 1
        for (int c = 0; c < 8; ++c) {
            __syncthreads();
#pragma unroll
            for (int q = 0; q < 4; ++q) { const int idx = q * NTHREADS + F.tid; *(LAS u32x4*)(F.lds + (idx >> 2) * RS + (idx & 3) * 16) = pre[q]; }
            if (c + 1 < 8) {
#pragma unroll
                for (int q = 0; q < 4; ++q) { const int idx = q * NTHREADS + F.tid; pre[q] = *(const u32x4*)(slab + (size_t)(idx >> 2) * 256 + (c + 1) * 32 + (idx & 3) * 8); } }
            __syncthreads();
            const unsigned nb = (unsigned)((c & 3) * 32);
#pragma unroll
            for (int h = 0; h < 2; ++h) {
                unsigned C[16];
#pragma unroll
                for (int s2 = 0; s2 < 2; ++s2) { const u32x4 w = *(const LAS u32x4*)(F.lds + F.tid * RS + (h * 2 + s2) * 16);
                    const float a[8] = {bflo(w.x), bfhi(w.x), bflo(w.y), bfhi(w.y), bflo(w.z), bfhi(w.z), bflo(w.w), bfhi(w.w)};
#pragma unroll
                    for (int i = 0; i < 8; ++i) C[s2 * 8 + i] = (sortable(a[i]) & ~0x7Fu) | (127u - (nb + (unsigned)(h * 16 + s2 * 8 + i))); }
                sort16_desc(C);
                if (c < 4) merge_top16(L1, C); else merge_top16(L2, C);
            }
        }
        float v1[16], v2[16]; unsigned x1[16], x2[16];
#pragma unroll
        for (int m = 0; m < 16; ++m) { v1[m] = unsortable(L1[m] & ~0x7Fu); v2[m] = unsortable(L2[m] & ~0x7Fu); x1[m] = (127u - (L1[m] & 0x7Fu)) << 7; x2[m] = 127u - (L2[m] & 0x7Fu); }
#pragma unroll
        for (int i = 0; i < 16; ++i)
#pragma unroll
            for (int j = 0; j < 16; ++j) if ((i + 1) * (j + 1) <= 16) { const unsigned key = (sortable(v1[i] + v2[j]) & ~0x3FFFu) | x1[i] | x2[j]; INS16(Fk, key); }
        float g[16]; const float mx = unsortable(Fk[0] & ~0x3FFFu); float sum = 0.f;
#pragma unroll
        for (int m = 0; m < 16; ++m) { g[m] = __expf(unsortable(Fk[m] & ~0x3FFFu) - mx); sum += g[m]; }
        const float inv = 1.0f / sum;
        const size_t pair = (size_t)blk * 512 + F.tid;
        int* eo = eidx + pair * 16; float* go = eg + pair * 16;
#pragma unroll
        for (int m = 0; m < 16; ++m) { eo[m] = (int)(Fk[m] & 0x3FFFu); go[m] = g[m] * inv; }
    }
    __syncthreads();
}


__device__ __forceinline__ int wave_sum_i(int v) {
#define DPPI(v, ctrl) __builtin_amdgcn_update_dpp(0, (v), (ctrl), 0xF, 0xF, true)
    v += DPPI(v, 0xB1); v += DPPI(v, 0x4E); v += DPPI(v, 0x141); v += DPPI(v, 0x140);
#undef DPPI
    return (__builtin_amdgcn_readlane(v, 0) + __builtin_amdgcn_readlane(v, 16)) + (__builtin_amdgcn_readlane(v, 32) + __builtin_amdgcn_readlane(v, 48));
}
__device__ __forceinline__ void l16_load_f32(const float* __restrict__ row, int lane, float (&v)[32]) {
#pragma unroll
    for (int c = 0; c < 2; ++c)
#pragma unroll
        for (int q = 0; q < 4; ++q) { const f32x4 a = *(const f32x4*)(row + c * 1024 + lane * 16 + q * 4);
#pragma unroll
            for (int i = 0; i < 4; ++i) v[c * 16 + q * 4 + i] = a[i]; }
}
__device__ __forceinline__ void l16_store_f32(float* __restrict__ row, int lane, const float (&v)[32]) {
#pragma unroll
    for (int c = 0; c < 2; ++c)
#pragma unroll
        for (int q = 0; q < 4; ++q) { f32x4 a;
#pragma unroll
            for (int i = 0; i < 4; ++i) a[i] = v[c * 16 + q * 4 + i];
            *(f32x4*)(row + c * 1024 + lane * 16 + q * 4) = a; }
}
__device__ __forceinline__ void l16_store_bf16(bf16_t* __restrict__ row, int lane, const float (&v)[32]) {
#pragma unroll
    for (int c = 0; c < 2; ++c)
#pragma unroll
        for (int q = 0; q < 2; ++q) { u32x4 w;
            w.x = cvt_pk_bf16(v[c * 16 + q * 8 + 0], v[c * 16 + q * 8 + 1]); w.y = cvt_pk_bf16(v[c * 16 + q * 8 + 2], v[c * 16 + q * 8 + 3]);
            w.z = cvt_pk_bf16(v[c * 16 + q * 8 + 4], v[c * 16 + q * 8 + 5]); w.w = cvt_pk_bf16(v[c * 16 + q * 8 + 6], v[c * 16 + q * 8 + 7]);
            *(u32x4*)(row + c * 1024 + lane * 16 + q * 8) = w; }
}
__device__ __forceinline__ float ub0(unsigned x) { float f; asm("v_cvt_f32_ubyte0 %0, %1" : "=v"(f) : "v"(x)); return f; }
__device__ __forceinline__ float ub1(unsigned x) { float f; asm("v_cvt_f32_ubyte1 %0, %1" : "=v"(f) : "v"(x)); return f; }
__device__ __forceinline__ float ub2(unsigned x) { float f; asm("v_cvt_f32_ubyte2 %0, %1" : "=v"(f) : "v"(x)); return f; }
__device__ __forceinline__ float ub3(unsigned x) { float f; asm("v_cvt_f32_ubyte3 %0, %1" : "=v"(f) : "v"(x)); return f; }
#define UB0(x) ub0(x)
#define UB1(x) ub1(x)
#define UB2(x) ub2(x)
#define UB3(x) ub3(x)
__device__ __forceinline__ float reduce_scatter8(const float (&p)[8], int lane) {
    const bool b0 = (lane & 1) != 0, b1 = (lane & 2) != 0, b2 = (lane & 4) != 0;
    float r1[4], r2[2];
#pragma unroll
    for (int j = 0; j < 4; ++j) { const float a = b0 ? p[2 * j + 1] : p[2 * j], b = b0 ? p[2 * j] : p[2 * j + 1]; r1[j] = a + DPPF(b, 0xB1); }
#pragma unroll
    for (int j = 0; j < 2; ++j) { const float a = b1 ? r1[2 * j + 1] : r1[2 * j], b = b1 ? r1[2 * j] : r1[2 * j + 1]; r2[j] = a + DPPF(b, 0x4E); }
    float r3;
    { const float a = b2 ? r2[1] : r2[0], b = b2 ? r2[0] : r2[1]; const float t = DPPF(b, 0x141); r3 = a + DPPF(t, 0x1B); }
    { const float t = DPPF(r3, 0x140); r3 += DPPF(t, 0x141); }
    { auto s = __builtin_amdgcn_permlane16_swap(__float_as_uint(r3), __float_as_uint(r3), false, false); r3 = __uint_as_float(s[0]) + __uint_as_float(s[1]); }
    { auto s = __builtin_amdgcn_permlane32_swap(__float_as_uint(r3), __float_as_uint(r3), false, false); r3 = __uint_as_float(s[0]) + __uint_as_float(s[1]); }
    return r3;
}
#define PIN16(a, o) asm volatile("" : "+v"(a[(o)+0]), "+v"(a[(o)+1]), "+v"(a[(o)+2]), "+v"(a[(o)+3]), "+v"(a[(o)+4]), "+v"(a[(o)+5]), "+v"(a[(o)+6]), "+v"(a[(o)+7]), \
    "+v"(a[(o)+8]), "+v"(a[(o)+9]), "+v"(a[(o)+10]), "+v"(a[(o)+11]), "+v"(a[(o)+12]), "+v"(a[(o)+13]), "+v"(a[(o)+14]), "+v"(a[(o)+15]))
template <int J> __device__ __forceinline__ unsigned lane_xor(unsigned v, const int lane) {
    if constexpr (J == 1) return (unsigned)__builtin_amdgcn_update_dpp(0, (int)v, 0xB1, 0xF, 0xF, true);
    else if constexpr (J == 2) return (unsigned)__builtin_amdgcn_update_dpp(0, (int)v, 0x4E, 0xF, 0xF, true);
    else if constexpr (J == 4) { const int t = __builtin_amdgcn_update_dpp(0, (int)v, 0x141, 0xF, 0xF, true); return (unsigned)__builtin_amdgcn_update_dpp(0, t, 0x1B, 0xF, 0xF, true); }
    else if constexpr (J == 8) { const int t = __builtin_amdgcn_update_dpp(0, (int)v, 0x140, 0xF, 0xF, true); return (unsigned)__builtin_amdgcn_update_dpp(0, t, 0x141, 0xF, 0xF, true); }
    else if constexpr (J == 16) { auto s = __builtin_amdgcn_permlane16_swap(v, v, false, false); return (lane & 16) ? s[0] : s[1]; }
    else { auto s = __builtin_amdgcn_permlane32_swap(v, v, false, false); return (lane & 32) ? s[0] : s[1]; }
}
template <int K, int J> __device__ __forceinline__ void sort128_stage(unsigned& k0, unsigned& k1, const int lane) {
    if constexpr (J == 64) { const unsigned lo = min(k0, k1), hi = max(k0, k1); k0 = lo; k1 = hi; }
    else {
        const unsigned p0 = lane_xor<J>(k0, lane), p1 = lane_xor<J>(k1, lane);
        const bool lower = (lane & J) == 0;
        const bool asc0 = (K == 128) ? true : ((lane & K) == 0), asc1 = (K == 128) ? true : (((64 + lane) & K) == 0);
        k0 = (lower == asc0) ? min(k0, p0) : max(k0, p0);
        k1 = (lower == asc1) ? min(k1, p1) : max(k1, p1);
    }
}
template <int K, int J> __device__ __forceinline__ void sort128_k(unsigned& k0, unsigned& k1, const int lane) {
    sort128_stage<K, J>(k0, k1, lane);
    if constexpr (J > 1) sort128_k<K, J / 2>(k0, k1, lane);
}
__device__ __forceinline__ void wave_sort128(unsigned& k0, unsigned& k1, const int lane) {
    sort128_k<2, 1>(k0, k1, lane); sort128_k<4, 2>(k0, k1, lane); sort128_k<8, 4>(k0, k1, lane); sort128_k<16, 8>(k0, k1, lane);
    sort128_k<32, 16>(k0, k1, lane); sort128_k<64, 32>(k0, k1, lane); sort128_k<128, 64>(k0, k1, lane);
}
#define DPPI_(v, ctrl) __builtin_amdgcn_update_dpp(0, (v), (ctrl), 0xF, 0xF, true)
template <int N> __device__ __forceinline__ float bcast8(float c) {
    const int t1 = __builtin_amdgcn_update_dpp(0, __float_as_int(c), 0x150 + N, 0xF, 0x3, false);
    return __int_as_float(__builtin_amdgcn_update_dpp(t1, __float_as_int(c), 0x158 + N, 0xF, 0xC, false));
}
__device__ __forceinline__ void peer_scales_to_lds(const Ctx& F, const bf16_t* __restrict__ s  ) {
    const u32x4* sp = (const u32x4*)s;
    for (int i = F.tid; i < NEXP * 8 / 16; i += NTHREADS) *(LAS u32x4*)(F.lds + i * 16) = sp[i];
    __syncthreads();
}
#define PEER_IDS(I, tt) do { const int* ip_ = eidx + (size_t)(tt) * 128 + g * 16; _Pragma("unroll") for (int c_ = 0; c_ < 4; ++c_) I[c_] = *(const u32x4*)(ip_ + c_ * 4); } while (0)
#define PEER_ID(I, k) (I[(k) >> 2][(k) & 3])
#define PEER_LD8(D, rs, I, b) do { _Pragma("unroll") for (int k_ = 0; k_ < 8; ++k_) D[k_] = __builtin_amdgcn_raw_buffer_load_b128(rs, (int)((PEER_ID(I, (b) * 8 + k_) << 7) + p16), 0, 0); } while (0)
#define PEER_SC8(S, I, b) do { _Pragma("unroll") for (int k_ = 0; k_ < 8; ++k_) S[k_] = (unsigned)*(const LAS unsigned short*)(F.lds + (PEER_ID(I, (b) * 8 + k_) << 3) + ph2); } while (0)
#define PEER_ZERO4(A, n) do { _Pragma("unroll") for (int z_ = 0; z_ < (n); ++z_) A[z_] = (u32x4){0u, 0u, 0u, 0u}; } while (0)
#define PEER_COPY4(A, B, n) do { _Pragma("unroll") for (int z_ = 0; z_ < (n); ++z_) A[z_] = B[z_]; } while (0)

__device__ __forceinline__ void peer_dots_phase(const Ctx& F, const unsigned char* __restrict__ h8, const int* __restrict__ eidx,
                                                const unsigned char* __restrict__ u4, const bf16_t* __restrict__ su, float* __restrict__ part) {
    const int x = F.bid & 7, q = F.bid >> 3, nq = (F.G - x + 7) >> 3, tstep = nq * NWAVES;
    peer_scales_to_lds(F, su + (size_t)x * NEXP * 4);
    const __amdgpu_buffer_rsrc_t r_u = __builtin_amdgcn_make_buffer_rsrc((void*)(u4 + (size_t)x * NEXP * 128), 0, NEXP * 128, 0x00020000);
#define PEER_HQ(H, tt) do { const unsigned char* hp_ = h8 + (size_t)(tt) * DM + (unsigned)((x * 8 + p) * 16); H[0] = *(const u32x4*)hp_; H[1] = *(const u32x4*)(hp_ + 1024); } while (0)
#define PEER_DOT8(D, S, H, keep) do { _Pragma("unroll") for (int k_ = 0; k_ < 8; ++k_) { int sh_ = 0, sl_ = 0; \
        sh_ = __builtin_amdgcn_sdot8((int)H[0].x, (int)D[k_].x, sh_, false); sl_ = __builtin_amdgcn_sdot8((int)H[1].x, (int)D[k_].x, sl_, false); \
        sh_ = __builtin_amdgcn_sdot8((int)H[0].y, (int)D[k_].y, sh_, false); sl_ = __builtin_amdgcn_sdot8((int)H[1].y, (int)D[k_].y, sl_, false); \
        sh_ = __builtin_amdgcn_sdot8((int)H[0].z, (int)D[k_].z, sh_, false); sl_ = __builtin_amdgcn_sdot8((int)H[1].z, (int)D[k_].z, sl_, false); \
        sh_ = __builtin_amdgcn_sdot8((int)H[0].w, (int)D[k_].w, sh_, false); sl_ = __builtin_amdgcn_sdot8((int)H[1].w, (int)D[k_].w, sl_, false); \
        int s_ = sh_ * 16 + sl_; s_ += DPPI_(s_, 0xB1);                       \
        float v_ = (float)s_ * __uint_as_float(S[k_] << 16); v_ += DPPF(v_, 0x4E); v_ += DPPF(v_, 0x141);     \
        keep = (p == k_) ? v_ : keep; } } while (0)
    int t = q * NWAVES + F.wave;
    u32x4 I0[4], I1[4], I2[4], H0[2], H1[2], Da[8], Db[8];
    PEER_ZERO4(I0, 4); PEER_ZERO4(I1, 4); PEER_ZERO4(I2, 4); PEER_ZERO4(H0, 2); PEER_ZERO4(H1, 2); PEER_ZERO4(Da, 8); PEER_ZERO4(Db, 8);
    { const int p = F.lane & 7, g = F.lane >> 3; const unsigned p16 = (unsigned)p * 16u;
      if (t < NTOK) { PEER_IDS(I0, t); PEER_HQ(H0, t); }
      if (t + tstep < NTOK) PEER_IDS(I1, t + tstep);
      if (t < NTOK) PEER_LD8(Da, r_u, I0, 0); }
#pragma unroll 1
    for (; t < NTOK; t += tstep) {
        int lane = F.lane; asm volatile("" : "+v"(lane));
        const int p = lane & 7, g = lane >> 3; const unsigned p16 = (unsigned)p * 16u, ph2 = (unsigned)(p >> 1) * 2u;
        const int tn = t + tstep, tnn = t + 2 * tstep;
        PEER_LD8(Db, r_u, I0, 1);
        __builtin_amdgcn_sched_barrier(0);
        if (tnn < NTOK) PEER_IDS(I2, tnn);
        if (tn < NTOK) PEER_HQ(H1, tn);
        unsigned Sa[8], Sb[8]; PEER_SC8(Sa, I0, 0); PEER_SC8(Sb, I0, 1);
        float keep0 = 0.f, keep1 = 0.f;
        __builtin_amdgcn_sched_barrier(0);
        PEER_DOT8(Da, Sa, H0, keep0);
        __builtin_amdgcn_sched_barrier(0);
        if (tn < NTOK) PEER_LD8(Da, r_u, I1, 0);
        __builtin_amdgcn_sched_barrier(0);
        PEER_DOT8(Db, Sb, H0, keep1);
        float* po = part + ((size_t)t * 8 + x) * 128 + g * 16 + p; po[0] = keep0; po[8] = keep1;
        PEER_COPY4(I0, I1, 4); PEER_COPY4(I1, I2, 4); PEER_COPY4(H0, H1, 2);
    }
    __syncthreads();
#undef PEER_HQ
#undef PEER_DOT8
}

__device__ __forceinline__ void peer_coef_phase(const Ctx& F, const float* __restrict__ part, const float* __restrict__ hs, const float* __restrict__ eg, const int* __restrict__ eidx,
                                                const bf16_t* __restrict__ sv  , unsigned short* __restrict__ ids, unsigned char* __restrict__ W8, unsigned* __restrict__ SC) {
    for (int idx = F.bid * NTHREADS + F.tid; idx < NTOK * 128; idx += F.G * NTHREADS) {
        const int t = idx >> 7, j = idx & 127;
        const float* pp = part + (size_t)t * 1024 + j;
        float s = 0.f;
#pragma unroll
        for (int x = 0; x < 8; ++x) s += pp[x * 128];
        const int e = eidx[idx];
        const float c = eg[idx] * gelu_erf(s * hs[t]);
        const u32x4 sc = *(const u32x4*)(sv + (size_t)e * 8);
        ids[idx] = (unsigned short)e;
        const int ee = j & 15, st = j >> 4, gB = (ee < 8) ? (ee >> 1) : ((ee - 8) >> 1), qq = (ee < 8) ? (ee & 1) : (2 + (ee & 1));
        unsigned char* wp = W8 + (size_t)t * 1024 + gB * 32 + st * 4 + qq;
        unsigned* sp = SC + (size_t)t * 64 + st;
        const float rs[8] = {bflo(sc.x), bfhi(sc.x), bflo(sc.y), bfhi(sc.y), bflo(sc.z), bfhi(sc.z), bflo(sc.w), bfhi(sc.w)};
#pragma unroll
        for (int x = 0; x < 8; ++x) {
            const float w = c * rs[x];
            float m = fabsf(w);
            m = fmaxf(m, DPPF(m, 0xB1)); m = fmaxf(m, DPPF(m, 0x4E)); m = fmaxf(m, DPPF(m, 0x141)); m = fmaxf(m, DPPF(m, 0x140));
            const int bexp = max((int)(__float_as_uint(m) >> 23), 16);
            const float fac = __uint_as_float((unsigned)(261 - bexp) << 23);
            wp[x * 128] = (unsigned char)(__builtin_amdgcn_cvt_pk_fp8_f32(w * fac, 0.f, 0, false) & 0xFF);
            if (ee == 0) { const unsigned sb1 = (unsigned)(bexp - 7); sp[x * 8] = sb1 * 0x01010101u; }
        }
    }
}

typedef int i32x8 __attribute__((ext_vector_type(8)));
#define PEER_CONST_SCALE 0
#define PEER_SELFTEST 0
__device__ __forceinline__ void peer_acc_phase(const Ctx& F, const unsigned short* __restrict__ ids, const unsigned char* __restrict__ W8, const unsigned* __restrict__ SC, const unsigned char* __restrict__ v4,
                                               const bf16_t* __restrict__ uin  , const float* __restrict__ lns  ,
                                               const float* __restrict__ g0, const float* __restrict__ b0, const float* __restrict__ gate  , bf16_t* __restrict__ y2) {
    const int x = F.bid & 7, q = F.bid >> 3, nq = (F.G - x + 7) >> 3, tstep = nq * NWAVES;
    { LAS float* lv = (LAS float*)F.lds;
      if (F.tid < 256) { lv[F.tid] = g0[x * 256 + F.tid]; lv[256 + F.tid] = b0[x * 256 + F.tid]; lv[512 + F.tid] = gate[x * 256 + F.tid]; lv[768 + F.tid] = gate[6144 + x * 256 + F.tid]; } }
    __syncthreads();
    const __amdgpu_buffer_rsrc_t r_v = __builtin_amdgcn_make_buffer_rsrc((void*)(v4 + (size_t)x * NEXP * 128), 0, NEXP * 128, 0x00020000);
    const __amdgpu_buffer_rsrc_t r_y = __builtin_amdgcn_make_buffer_rsrc((void*)y2, 0, NTOK * DM * 2, 0x00020000);
    unsigned sel[8];
    { const int n0 = F.lane & 15;
#pragma unroll
      for (int i = 0; i < 4; ++i)
#pragma unroll
          for (int h = 0; h < 2; ++h) sel[2 * i + h] = (n0 < 8 && (n0 >> 2) == h) ? ((0x0C0C0C0Cu & ~(0xFFu << (8 * (n0 & 3)))) | ((unsigned)i << (8 * (n0 & 3)))) : 0x0C0C0C0Cu; }
#define PB_IDS(I, tt) do { const unsigned short* rp_ = ids + (size_t)(tt) * 128 + 8 * g8; I[0] = *(const u32x4*)rp_; I[1] = *(const u32x4*)(rp_ + 64); } while (0)
#define PB_CFS(C, tt) do { const unsigned char* rp_ = W8 + ((size_t)(tt) * 8 + x) * 128 + 32 * kg; const unsigned* sp_ = SC + ((size_t)(tt) * 8 + x) * 8; \
        C[0] = *(const u32x4*)rp_; C[1] = *(const u32x4*)(rp_ + 16); C[2] = *(const u32x4*)sp_; C[3] = *(const u32x4*)(sp_ + 4); } while (0)
#define PB_ID(I, h, k) (((k) & 1) ? (I[h][(k) >> 1] >> 16) : (I[h][(k) >> 1] & 0xFFFFu))
#define PB_LD8(D, I, h) do { _Pragma("unroll") for (int k_ = 0; k_ < 8; ++k_) D[k_] = __builtin_amdgcn_raw_buffer_load_b128(r_v, (int)((PB_ID(I, h, k_) << 7) + p16), 0, 0); } while (0)
#define PB_WR8(D) do { _Pragma("unroll") for (int k_ = 0; k_ < 8; ++k_) *(LAS u32x4*)(wl + k_ * 1024 + lane16) = D[k_]; } while (0)
#define PB_STEP(s) do { \
            unsigned a0_[4], a1_[4]; _Pragma("unroll") for (int i_ = 0; i_ < 4; ++i_) { const LAS unsigned* ap_ = (const LAS unsigned*)(wl + (4 * (kg & 1) + i_) * 1024 + (2 * ((s) & 3) + (kg >> 1)) * 128 + idx8); a0_[i_] = ap_[0]; a1_[i_] = ap_[1]; } \
            const unsigned W8_ = C0[(s) >> 2][(s) & 3]; const int scale_b = (int)C0[2 + ((s) >> 2)][(s) & 3];        \
            i32x8 Bm; _Pragma("unroll") for (int j = 0; j < 8; ++j) Bm[j] = (int)__builtin_amdgcn_perm(W8_, W8_, sel[j]); \
            const i32x8 A0 = {(int)a0_[0], (int)a0_[1], (int)a0_[2], (int)a0_[3], 0, 0, 0, 0}; \
            const i32x8 A1 = {(int)a1_[0], (int)a1_[1], (int)a1_[2], (int)a1_[3], 0, 0, 0, 0}; \
            acc0 = __builtin_amdgcn_mfma_scale_f32_16x16x128_f8f6f4(A0, Bm, acc0, 4, 0, 0, 0x7F7F7F7F, 0, scale_b); \
            acc1 = __builtin_amdgcn_mfma_scale_f32_16x16x128_f8f6f4(A1, Bm, acc1, 4, 0, 0, 0x7F7F7F7F, 0, scale_b); } while (0)
    int t = q * NWAVES + F.wave;
    u32x4 I0[2], I1[2], I2[2], Da[8], Db[8], C0[4], C1[4];
#pragma unroll
    for (int i = 0; i < 2; ++i) { I0[i] = (u32x4){0u, 0u, 0u, 0u}; I1[i] = I0[i]; I2[i] = I0[i]; }
#pragma unroll
    for (int i = 0; i < 8; ++i) { Da[i] = (u32x4){0u, 0u, 0u, 0u}; Db[i] = Da[i]; }
#pragma unroll
    for (int i = 0; i < 4; ++i) { C0[i] = (u32x4){0u, 0u, 0u, 0u}; C1[i] = C0[i]; }
    { const int kg = F.lane >> 4, g8 = F.lane >> 3; const unsigned p16 = (unsigned)(F.lane & 7) * 16u;
      if (t < NTOK) { PB_IDS(I0, t); PB_CFS(C0, t); }
      if (t + tstep < NTOK) PB_IDS(I1, t + tstep);
      if (t < NTOK) PB_LD8(Da, I0, 0); }
#pragma unroll 1
    for (; t < NTOK; t += tstep) {
        int lane = F.lane; asm volatile("" : "+v"(lane));
        const int idx = lane & 15, kg = lane >> 4, g8 = lane >> 3; const unsigned idx8 = (unsigned)idx * 8u, p16 = (unsigned)(lane & 7) * 16u, lane16 = (unsigned)lane * 16u;
        LAS unsigned char* wl = F.lds + 4096 + F.wave * 8192;
        const int tn = t + tstep, tnn = t + 2 * tstep;
        const unsigned colb = (unsigned)(x * 256 + kg * 64 + idx * 8);
        f32x4 acc0 = {0.f, 0.f, 0.f, 0.f}, acc1 = {0.f, 0.f, 0.f, 0.f};
        PB_LD8(Db, I0, 1);
        __builtin_amdgcn_sched_barrier(0);
        if (tnn < NTOK) PB_IDS(I2, tnn);
        if (tn < NTOK) PB_CFS(C1, tn);
        const u32x4 xw = *(const u32x4*)(uin + (size_t)t * DM + (idx < 8 ? colb : 0u));
        const float mu = lns[2 * t], rstd = lns[2 * t + 1];
        __builtin_amdgcn_sched_barrier(0);
        PB_WR8(Da);
        PB_STEP(0); PB_STEP(1); PB_STEP(2); PB_STEP(3);
        __builtin_amdgcn_sched_barrier(0);
        if (tn < NTOK) PB_LD8(Da, I1, 0);
        __builtin_amdgcn_sched_barrier(0);
        PB_WR8(Db);
        PB_STEP(4); PB_STEP(5); PB_STEP(6); PB_STEP(7);
        __builtin_amdgcn_sched_barrier(0);
        {
            const LAS float* lv = (const LAS float*)F.lds + kg * 64 + idx * 8;
            const LAS float* gp = lv + 512 + (t / SEQ) * 256;
            const f32x4 ga = *(const LAS f32x4*)lv, gb = *(const LAS f32x4*)(lv + 4), ba = *(const LAS f32x4*)(lv + 256), bb = *(const LAS f32x4*)(lv + 260), ta = *(const LAS f32x4*)gp, tb = *(const LAS f32x4*)(gp + 4);
            const float xr[8] = {bflo(xw.x), bfhi(xw.x), bflo(xw.y), bfhi(xw.y), bflo(xw.z), bfhi(xw.z), bflo(xw.w), bfhi(xw.w)};
            float val[8];
#pragma unroll
            for (int r = 0; r < 4; ++r) { const float xa_ = fmaf((xr[r] - mu) * rstd, ga[r], ba[r]), xb_ = fmaf((xr[4 + r] - mu) * rstd, gb[r], bb[r]);
#if PEER_CONST_SCALE
                val[r] = fmaf(ta[r] * (1.0f / 1024.0f), acc0[r], xa_ * ALPHA); val[4 + r] = fmaf(tb[r] * (1.0f / 1024.0f), acc1[r], xb_ * ALPHA); }
#else
                val[r] = fmaf(ta[r], acc0[r], xa_ * ALPHA); val[4 + r] = fmaf(tb[r], acc1[r], xb_ * ALPHA); }
#endif
            __builtin_amdgcn_raw_buffer_store_b128((u32x4){cvt_pk_bf16(val[0], val[1]), cvt_pk_bf16(val[2], val[3]), cvt_pk_bf16(val[4], val[5]), cvt_pk_bf16(val[6], val[7])}, r_y,
                                                   (int)(idx < 8 ? ((unsigned)t * (unsigned)DM + colb) * 2u : 0xFFFFFFF0u), 0, 0);
        }
        I0[0] = I1[0]; I0[1] = I1[1]; I1[0] = I2[0]; I1[1] = I2[1];
#pragma unroll
        for (int i = 0; i < 4; ++i) C0[i] = C1[i];
    }
    __syncthreads();
#undef PB_IDS
#undef PB_CFS
#undef PB_ID
#undef PB_LD8
#undef PB_WR8
#undef PB_STEP
}

__device__ __forceinline__ void peer_ln_phase(const Ctx& F, const bf16_t* __restrict__ y2, const float* __restrict__ lg, const float* __restrict__ lb, const float* __restrict__ modnext  ,
                                              float* __restrict__ xout32  , bf16_t* __restrict__ xout16, bf16_t* __restrict__ hout  , float* __restrict__ hsc) {
    LAS float* lv = (LAS float*)F.lds;
    lds_copy_vec(F, lv, lg, 2048); lds_copy_vec(F, lv + 2048, lb, 2048);
    if (modnext) { lds_copy_vec(F, lv + 4096, modnext, 4096); lds_copy_vec(F, lv + 8192, modnext + 6144, 4096); }
    __syncthreads();
    for (int t = F.bid * NWAVES + F.wave; t < NTOK; t += F.G * NWAVES) {
        float v[32]; row_load_bf16(y2 + (size_t)t * DM, F.lane, v);
        row_norm(v); row_affine_lds(v, lv, lv + 2048, F.lane);
        if (xout32) row_store_f32(xout32 + (size_t)t * DM, F.lane, v); else row_store_bf16(xout16 + (size_t)t * DM, F.lane, v);
        if (modnext) { const LAS float* mr = lv + 4096 + (t / SEQ) * 4096; row_norm(v); row_modulate_lds(v, mr, mr + 2048, F.lane); row_store_i8((signed char*)hout + (size_t)t * DM, hsc + t, F.lane, v); }
    }
    __syncthreads();
#if PEER_SELFTEST
    if (xout32 && F.bid == 0 && F.wave == 0) {
        constexpr int GA = 1, JA = 20;
        i32x8 At = {0, 0, 0, 0, 0, 0, 0, 0}; At[JA >> 3] = ((F.lane >> 4) == GA) ? (0x2 << (4 * (JA & 7))) : 0;
        float one = 1.0f; asm volatile("" : "+v"(one));
        const int w8 = __builtin_amdgcn_cvt_pk_fp8_f32(one, one, 0, false) & 0xFF;
        int found = -1, nm = 0;
#pragma unroll 1
        for (int gb = 0; gb < 4; ++gb) {
#pragma unroll
            for (int jb = 0; jb < 32; ++jb) {
                i32x8 Bt = {0, 0, 0, 0, 0, 0, 0, 0}; Bt[jb >> 2] = ((F.lane >> 4) == gb) ? (w8 << (8 * (jb & 3))) : 0;
                f32x4 d = {0.f, 0.f, 0.f, 0.f};
                d = __builtin_amdgcn_mfma_scale_f32_16x16x128_f8f6f4(At, Bt, d, 4, 0, 0, 0x7F7F7F7F, 0, 0x7F7F7F7F);
                const float tot = wave_sum(fabsf(d[0]) + fabsf(d[1]) + fabsf(d[2]) + fabsf(d[3]));
                if (tot != 0.f) { found = gb * 32 + jb; nm += 1; }
            }
        }
        if (F.lane == 0) xout32[0] = (float)(10 * (1 + (found >> 3)) + (nm > 1 ? 500 : 0));
    }
    __syncthreads();
#endif
}
#undef PEER_IDS
#undef PEER_ID
#undef PEER_LD8
#undef PEER_SC8
#undef PEER_ZERO4
#undef PEER_COPY4

constexpr int LDS_PARAMS = LDS_BYTES - 256;
__device__ __forceinline__ unsigned long long ld_param(LAS unsigned char* lds, int k) {
    const u32x2 v = *(volatile LAS u32x2*)(lds + LDS_PARAMS + 8 * k);
    const unsigned lo = __builtin_amdgcn_readfirstlane(v.x), hi = __builtin_amdgcn_readfirstlane(v.y);
    return ((unsigned long long)hi << 32) | lo;
}
template <class T> struct rm_ptr; template <class T> struct rm_ptr<T*> { typedef T type; };
template <class P> __device__ __forceinline__ P as_global(unsigned long long v) { typedef typename rm_ptr<P>::type T; return (P)(__attribute__((address_space(1))) T*)v; }
#define PARG(T, k) as_global<T>(ld_param(F.lds, (k)))
constexpr int N_PHASES = 3 + 2 * (7 + 6) + 2 * (7 + 6);

__global__ __launch_bounds__(NTHREADS, 2) void mega(Params p, int lo, int hi) {
    extern __shared__ __attribute__((aligned(16))) unsigned char lds_raw[];
    volatile LAS unsigned* misc = (volatile LAS unsigned*)((LAS unsigned char*)lds_raw + LDS_BYTES - 64);
    if (threadIdx.x < 4) misc[threadIdx.x] = 0u;
    if (threadIdx.x < 22) ((LAS unsigned long long*)((LAS unsigned char*)lds_raw + LDS_PARAMS))[threadIdx.x] = ((const __attribute__((address_space(4))) unsigned long long*)__builtin_amdgcn_kernarg_segment_ptr())[threadIdx.x];
    const int wave0 = __builtin_amdgcn_readfirstlane(threadIdx.x >> 6);
    __syncthreads();
    if (hi - lo > 1) (void)xcd_barrier_post((unsigned*)ld_param((LAS unsigned char*)lds_raw, 21), misc);
#define GRID_BARRIER() do { unsigned zb_ = 0u; asm volatile("" : "+v"(zb_)); XcdBarrier bar_; bar_.bar = (unsigned*)ld_param((LAS unsigned char*)lds_raw, 21); bar_.x = xb_xcc_id(); bar_.st = misc; xcd_barrier(bar_, wave0 == 0 && __builtin_amdgcn_mbcnt_hi(~0u, __builtin_amdgcn_mbcnt_lo(~0u, zb_)) == 0u); } while (0)

#define modp   ((float*)(ws + WS_MODP))
#define mod    ((float*)(ws + WS_MOD))
#define tw     ((float2*)(ws + WS_TW))
#define rope   ((float2*)(ws + WS_ROPE))
#define w_fpin ((bf16_t*)(ws + WS_WFPIN))
#define w_fpout ((bf16_t*)(ws + WS_WFPOUT))
#define w_atin ((bf16_t*)(ws + WS_WATIN))
#define w_atout ((bf16_t*)(ws + WS_WATOUT))
#define w_pq   ((bf16_t*)(ws + WS_WPQ))
#define w_fw   ((bf16_t*)(ws + WS_WFW))
#define w_pw   ((bf16_t*)(ws + WS_WPW))
#define w_sk   ((bf16_t*)(ws + WS_WSK))
#define w_sc   ((bf16_t*)(ws + WS_WSC))
#define kcb    ((bf16_t*)(ws + WS_KC))
#define vcb    ((bf16_t*)(ws + WS_VC))
#define u8b    ((unsigned char*)(ws + WS_UB))
#define v8b    ((unsigned char*)(ws + WS_VB))
#define su_    ((bf16_t*)(ws + WS_SU))
#define sv_    ((bf16_t*)(ws + WS_SV))
#define h8b    ((unsigned char*)(ws + WS_H8))
#define hs_    ((float*)(ws + WS_HS))
#define xa     ((bf16_t*)(ws + WS_XA))
#define xu     ((bf16_t*)(ws + WS_XU))
#define hbuf   ((bf16_t*)(ws + WS_H))
#define proj   ((bf16_t*)(ws + WS_PROJ))
#define ymix   ((bf16_t*)(ws + WS_YMIX))
#define pq     ((float*)(ws + WS_PQ))
#define yr     ((float*)(ws + WS_YR))
#define yi     ((float*)(ws + WS_YI))
#define pbuf   ((bf16_t*)(ws + WS_PBUF))
#define qp     ((bf16_t*)(ws + WS_QP))
#define eidx   ((int*)(ws + WS_EIDX))
#define eg     ((float*)(ws + WS_EG))
#define lns_   ((float*)(ws + WS_LNS))
#define coef_  ((float*)(ws + WS_COEF))
#define pw_    ((bf16_t*)(ws + WS_PW))
#define wsc8_  ((signed char*)(ws + WS_WSC8))
#define wss_   ((float*)(ws + WS_WSS))
#define win8_  ((signed char*)(ws + WS_WIN8))
#define wins_  ((float*)(ws + WS_WINS))
#define hs2_   ((float*)(ws + WS_HS2))
#define wout8_ ((signed char*)(ws + WS_WOUT8))
#define wouts_ ((float*)(ws + WS_WOUTS))
#define ys_    ((float*)(ws + WS_YS))
    int ph = 0;
#ifndef SITE_MASK
#define SITE_MASK 0xFFFFFFFFu
#endif
#ifndef PROBE_P0
#define PROBE_P0 0
#endif
#ifndef PROBE_REPEAT_MASK
#define PROBE_REPEAT_MASK 0u
#endif
#define PH_BEGIN(id) if ((((SITE_MASK) >> (id)) & 1u) && ph >= lo && ph < hi) { for (int rep_ = ((((PROBE_REPEAT_MASK) >> (id)) & 1u) ? 0 : 1); rep_ < 2; ++rep_) { if (rep_ == 1 && ((((PROBE_REPEAT_MASK) >> (id)) & 1u))) __syncthreads(); \
        Ctx F; F.lds = (LAS unsigned char*)lds_raw; { unsigned z_ = 0u; asm volatile("" : "+v"(z_)); F.lane = (int)__builtin_amdgcn_mbcnt_hi(~0u, __builtin_amdgcn_mbcnt_lo(~0u, z_)); } F.wave = wave0; F.tid = wave0 * 64 + F.lane; \
        { int g_ = gridDim.x, b_ = blockIdx.x; asm volatile("" : "+s"(g_), "+s"(b_)); F.G = g_; F.bid = b_; } \
        unsigned char* ws = as_global<unsigned char*>(ld_param(F.lds, 21));
#define PH_END   } if (ph + 1 < hi) GRID_BARRIER(); } ++ph;

    PH_BEGIN(0)
        adaln_partial(F, PARG(const float*, 1), PARG(const float*, 2), modp);
        transpose_job(F, PARG(const float*, 6), w_fpin, 2048, 2048, 2);
        transpose_job(F, PARG(const float*, 10), w_fpout, 2048, 2048, 2);
        transpose_job(F, PARG(const float*, 11), w_atin, 2048, 4608, 2);
        transpose_job(F, PARG(const float*, 15), w_atout, 2048, 2048, 2);
        cvt_stream(F, PARG(const float*, 16), w_pq, (size_t)4 * 2048 * 2048 / 8);
        transpose_job(F, PARG(const float*, 8), w_pw, 256, 256, 8);
        fourier_weights(F, PARG(const float*, 7), w_fw);
        make_tables(F, tw, rope);
        make_subkeys(F, PARG(const float*, 17), w_sk);
        quant4_rows<true>(F, PARG(const float*, 18), u8b, su_, 4 * NEXP);
        quant_fp4_rows(F, PARG(const float*, 19), v8b, sv_, 4 * NEXP);
#if PROBE_P0 == 1
        quant4_rows<true>(F, PARG(const float*, 18), u8b, su_, 4 * NEXP);
        quant_fp4_rows(F, PARG(const float*, 19), v8b, sv_, 4 * NEXP);
#endif
    PH_END
    PH_BEGIN(1)
        adaln_reduce(F, modp, PARG(const float*, 3), mod);
        { pg8::StaticOrder S; S.init(32, 8, F.G, F.bid);
          pg8::ScoreFoldOps O{w_sk, w_pq};
          pg8::EpiBf16 E{w_sc, DM, 0, nullptr};
          pg8::gemm_phase(F.tid, F.lds, 256, O, S, E); }
    PH_END
    PH_BEGIN(2)
        ln_mod_phase(F, PARG(const float*, 0), mod, (signed char*)hbuf, hs2_);
        quant_wsc_rows(F, w_sc, wsc8_, wss_, 4 * 2048);
        quant_wsc_rows(F, w_fpin, win8_, wins_, 2 * 2048);
        quant_wsc_rows(F, w_atin, win8_ + (size_t)2 * 2048 * 2048, wins_ + 2 * 2048, 2 * 4608);
        quant_wsc_rows(F, w_fpout, wout8_, wouts_, 2 * 2048);
        quant_wsc_rows(F, w_atout, wout8_ + (size_t)2 * 2048 * 2048, wouts_ + 2 * 2048, 2 * 2048);
    PH_END

#pragma clang loop unroll(full)
    for (int l = 0; l < DEPTH; ++l) {
        const int i = l >> 1;
        if ((l & 1) == 0) {
            PH_BEGIN(3)
                pg8::StaticOrder S; S.init(NTOK / 256, 8, F.G, F.bid);
                pg8::PlainOps O{hbuf, (const bf16_t*)(win8_ + (size_t)i * 2048 * 2048), DM / 2, DM / 2};
                pg8::EpiI8Score E{proj, DM, hs2_, wins_ + (size_t)i * 2048};
                pg8::gemm_phase<pg8::EpiI8Score, pg8::PlainOps, true>(F.tid, F.lds, DM / 2, O, S, E);
            PH_END
            PH_BEGIN(4)
                pg8::StaticOrder S; S.init(NTOK / 256, 8, F.G, F.bid);
                pg8::GroupOps O{proj, w_fw + (size_t)i * 4 * 512 * 256, DM, 256, 2, 256};
                pg8::EpiBf16 E{(bf16_t*)pq, DM, 0, nullptr};
                pg8::gemm_phase(F.tid, F.lds, 256, O, S, E);
                pool_phase(F, proj, pbuf);
            PH_END
            PH_BEGIN(5)
                dft1_phase(F, (const bf16_t*)pq, tw, (bf16_t*)yr, (bf16_t*)yi);
                pg8::StaticOrder S; S.init(NTOK / 256, 4, F.G, F.bid);
                pg8::GroupOps O{pbuf, w_pw + (size_t)i * 4 * 256 * 256, 1024, 256, 1, 256};
                pg8::EpiBf16 E{ymix, DM, 1024, PARG(const float*, 9) + (size_t)i * 1024};
                pg8::gemm_phase(F.tid, F.lds, 256, O, S, E);
            PH_END
            PH_BEGIN(6)
                dft2_phase(F, (const bf16_t*)yr, (const bf16_t*)yi, ymix);
            PH_END
            PH_BEGIN(21)
                quant_rows_phase(F, ymix, (signed char*)pbuf, ys_);
            PH_END
            PH_BEGIN(7)
                pg8::StaticOrder S; S.init(NTOK / 256, 8, F.G, F.bid);
                pg8::PlainOps O{pbuf, (const bf16_t*)(wout8_ + (size_t)i * 2048 * 2048), DM / 2, DM / 2};
                if (l == 0) { pg8::EpiResid<false, true> E{xu, PARG(const float*, 0), mod + (size_t)(l * 2) * 2 * 6144 + 4096, ys_, wouts_ + (size_t)i * 2048}; pg8::gemm_phase<pg8::EpiResid<false, true>, pg8::PlainOps, true>(F.tid, F.lds, DM / 2, O, S, E); }
                else { pg8::EpiResid<true, true> E{xu, xa, mod + (size_t)(l * 2) * 2 * 6144 + 4096, ys_, wouts_ + (size_t)i * 2048}; pg8::gemm_phase<pg8::EpiResid<true, true>, pg8::PlainOps, true>(F.tid, F.lds, DM / 2, O, S, E); }
            PH_END
        } else {
            PH_BEGIN(8)
                pg8::StaticOrder S; S.init(NTOK / 256, 18, F.G, F.bid);
                pg8::PlainOps O{hbuf, (const bf16_t*)(win8_ + (size_t)2 * 2048 * 2048 + (size_t)i * 4608 * 2048), DM / 2, DM / 2};
                pg8::EpiI8Score E{proj, ATT_IN, hs2_, wins_ + 2 * 2048 + (size_t)i * 4608};
                pg8::gemm_phase<pg8::EpiI8Score, pg8::PlainOps, true>(F.tid, F.lds, DM / 2, O, S, E);
            PH_END
            PH_BEGIN(9)
                qk_norm_rope_phase(F, proj, PARG(const float*, 12) + i * 128, PARG(const float*, 13) + i * 128, rope, kcb, vcb);
            PH_END
            PH_BEGIN(10)
                for (int it = F.bid; it < 2 * 8 * 32; it += F.G) {
                    const int hq = it & 7, qb = (it >> 3) & 31, b = it >> 8, kvh = hq >> 2;
                    const bf16_t* Q = proj + ((size_t)b * SEQ + qb * 256) * ATT_IN + hq * 128;
                    const bf16_t* Kp = kcb + (size_t)(b * 2 + kvh) * SEQ * 128;
                    const bf16_t* Vp = vcb + (size_t)(b * 2 + kvh) * SEQ * 128;
                    bf16_t* Op = ymix + ((size_t)b * SEQ + qb * 256) * DM + hq * 128;
                    att::attn_dense_body(Q, Kp, Vp, Op, SEQ, (char*)lds_raw, F.tid);
                }
            PH_END
            PH_BEGIN(17)
                natten_mfma_phase(F, proj, PARG(const float*, 14) + (size_t)i * 8 * 15 * 31, ymix);
            PH_END
            PH_BEGIN(21)
                quant_rows_phase(F, ymix, (signed char*)pbuf, ys_);
            PH_END
            PH_BEGIN(11)
                pg8::StaticOrder S; S.init(NTOK / 256, 8, F.G, F.bid);
                pg8::PlainOps O{pbuf, (const bf16_t*)(wout8_ + (size_t)(2 + i) * 2048 * 2048), DM / 2, DM / 2};
                if (l == 0) { pg8::EpiResid<false, true> E{xu, PARG(const float*, 0), mod + (size_t)(l * 2) * 2 * 6144 + 4096, ys_, wouts_ + (size_t)(2 + i) * 2048}; pg8::gemm_phase<pg8::EpiResid<false, true>, pg8::PlainOps, true>(F.tid, F.lds, DM / 2, O, S, E); }
                else { pg8::EpiResid<true, true> E{xu, xa, mod + (size_t)(l * 2) * 2 * 6144 + 4096, ys_, wouts_ + (size_t)(2 + i) * 2048}; pg8::gemm_phase<pg8::EpiResid<true, true>, pg8::PlainOps, true>(F.tid, F.lds, DM / 2, O, S, E); }
            PH_END
        }
        PH_BEGIN(12)
            ln2_phase(F, xu, PARG(const float*, 4) + (size_t)(l * 2) * DM, PARG(const float*, 5) + (size_t)(l * 2) * DM, mod + (size_t)(l * 2 + 1) * 2 * 6144, (signed char*)hbuf, h8b, hs_, lns_);
        PH_END
        PH_BEGIN(13)
            pg8::StaticOrder S; S.init(NTOK / 256, 8, F.G, F.bid);
            pg8::PlainOps O{hbuf, (const bf16_t*)(wsc8_ + (size_t)l * 2048 * 2048), DM / 2, DM / 2};
            pg8::EpiI8Score E{(bf16_t*)pq, DM, hs_, wss_ + (size_t)l * 2048};
            pg8::gemm_phase<pg8::EpiI8Score, pg8::PlainOps, true>(F.tid, F.lds, DM / 2, O, S, E);
        PH_END
        PH_BEGIN(15)
            topk_phase(F, (const bf16_t*)pq, eidx, eg);
        PH_END
        PH_BEGIN(16)
            peer_dots_phase(F, h8b, eidx, u8b + (size_t)l * NEXP * 1024, su_ + (size_t)l * NEXP * 32, (float*)qp);
        PH_END
        PH_BEGIN(18)
            peer_coef_phase(F, (const float*)qp, hs_, eg, eidx, sv_ + (size_t)l * NEXP * 8, (unsigned short*)coef_, (unsigned char*)pw_, (unsigned*)((unsigned char*)pw_ + (size_t)NTOK * 1024));
        PH_END
        PH_BEGIN(19)
            peer_acc_phase(F, (const unsigned short*)coef_, (const unsigned char*)pw_, (const unsigned*)((const unsigned char*)pw_ + (size_t)NTOK * 1024), v8b + (size_t)l * NEXP * 1024, xu, lns_,
                           PARG(const float*, 4) + (size_t)(l * 2) * DM, PARG(const float*, 5) + (size_t)(l * 2) * DM, mod + (size_t)(l * 2 + 1) * 2 * 6144 + 4096, ymix);
        PH_END
        PH_BEGIN(20)
            const bool lastl = (l == DEPTH - 1);
            peer_ln_phase(F, ymix, PARG(const float*, 4) + (size_t)(l * 2 + 1) * DM, PARG(const float*, 5) + (size_t)(l * 2 + 1) * DM,
                          lastl ? nullptr : mod + (size_t)((l + 1) * 2) * 2 * 6144, lastl ? PARG(float*, 20) : (float*)nullptr, xa, hbuf, hs2_);
        PH_END
    }
#undef PH_BEGIN
#undef PH_END
}

extern "C" void kernel_launch(void* const* d_in, const int* in_sizes, int n_in, void* d_out, int out_size, void* d_ws, size_t ws_size, hipStream_t stream) {
    static int grid = 0;
    if (grid == 0) {
        if (n_in != 20 || out_size != NTOK * DM || ws_size < WS_END) { fprintf(stderr, "kernel_launch: unexpected shapes: n_in %d out %d ws %zu (need %zu)\n", n_in, out_size, ws_size, (size_t)WS_END); grid = -1; return; }
        int dev = 0, cus = 0, per_cu = 0;
        if (hipGetDevice(&dev) != hipSuccess || hipDeviceGetAttribute(&cus, hipDeviceAttributeMultiprocessorCount, dev) != hipSuccess) { grid = -1; return; }
        if (hipFuncSetAttribute((const void*)mega, hipFuncAttributeMaxDynamicSharedMemorySize, LDS_BYTES) != hipSuccess) { fprintf(stderr, "kernel_launch: hipFuncSetAttribute failed\n"); grid = -1; return; }
        if (hipOccupancyMaxActiveBlocksPerMultiprocessor(&per_cu, (const void*)mega, NTHREADS, LDS_BYTES) != hipSuccess || per_cu < 1) fprintf(stderr, "kernel_launch: occupancy query reports %d\n", per_cu);
        (void)hipGetLastError();
        grid = cus;
    }
    if (grid < 0) return;
    hipMemsetAsync((char*)d_ws + WS_BAR, 0, 16384, stream);
    Params p{};
    const float** pp = (const float**)&p;
    for (int i = 0; i < 20; ++i) pp[i] = (const float*)d_in[i];
    p.out = (float*)d_out; p.ws = (unsigned char*)d_ws;
#if MK_SINGLE_LAUNCH
    hipLaunchKernelGGL(mega, dim3(grid), dim3(NTHREADS), LDS_BYTES, stream, p, 0, N_PHASES);
#else
    for (int k = 0; k < N_PHASES; ++k) hipLaunchKernelGGL(mega, dim3(grid), dim3(NTHREADS), LDS_BYTES, stream, p, k, k + 1);
#endif
}
```
